# Optimizing an MI355X kernel written in HIP

```python
import jax, jax.numpy as jnp
from jax import lax
import numpy as np

D_MODEL = 1024
BATCH = 4
SEQ = 8192
DEPTH = 1

ATTN_HEADS = 8
HEAD_DIM = D_MODEL // 16
ATTN_WIDTH = ATTN_HEADS * HEAD_DIM
ROPE_DIM = HEAD_DIM // 4
ROPE_THETA = 500000.0
MOBA_BLOCK = 256
MOBA_TOP_K = 3
QUERY_CHUNK = 64
POOL_WINDOWS = (2, 4, 8, 16)
POOL_GROUPS = len(POOL_WINDOWS)
POOL_WIDTH = D_MODEL // 2
POOL_GROUP_DIM = POOL_WIDTH // POOL_GROUPS
N_BRANCHES = 2
IN_WIDTH = 3 * ATTN_WIDTH + POOL_WIDTH + N_BRANCHES * D_MODEL
D_FF = 2816
CONV_WIDTH = 3
EPS = 1e-6
NEG_INF = -1e30

kernel_name = "hybrid_moba_pool_convffn"


def rmsnorm(x, g):
    xf = x.astype(jnp.float32)
    y = xf * lax.rsqrt(jnp.mean(xf * xf, axis=-1, keepdims=True) + EPS)
    return (y * g.astype(jnp.float32)).astype(x.dtype)


def apply_partial_rotary(x, positions):
    half = ROPE_DIM // 2
    inv_freq = ROPE_THETA ** (-jnp.arange(half, dtype=jnp.float32) / half)
    ang = positions.astype(jnp.float32)[:, None] * inv_freq[None, :]
    cos = jnp.cos(ang).astype(x.dtype)
    sin = jnp.sin(ang).astype(x.dtype)
    x1 = x[..., :half]
    x2 = x[..., half:ROPE_DIM]
    return jnp.concatenate([x1 * cos - x2 * sin, x2 * cos + x1 * sin, x[..., ROPE_DIM:]], axis=-1)


def moba_attention(q, k, v):
    B, H, S, Dh = q.shape
    nb = -(-S // MOBA_BLOCK)
    pad = nb * MOBA_BLOCK - S
    k_p = jnp.pad(k, ((0, 0), (0, 0), (0, pad), (0, 0)))
    v_p = jnp.pad(v, ((0, 0), (0, 0), (0, pad), (0, 0)))
    k_blk = k_p.reshape(B, H, nb, MOBA_BLOCK, Dh)
    v_blk = v_p.reshape(B, H, nb, MOBA_BLOCK, Dh)
    k_mean = jnp.mean(k_blk.astype(jnp.float32), axis=3).astype(k.dtype)
    top_k = min(MOBA_TOP_K, nb)
    scale = Dh ** -0.5
    n_chunks = S // QUERY_CHUNK
    gather_blocks = jax.vmap(jax.vmap(lambda kb, idx: kb[idx]))

    def chunk(c):
        start = c * QUERY_CHUNK
        qc = lax.dynamic_slice_in_dim(q, start, QUERY_CHUNK, axis=2)
        q_pos = start + jnp.arange(QUERY_CHUNK)
        own = start // MOBA_BLOCK
        s_blk = jnp.einsum('bhqd,bhnd->bhqn', qc, k_mean).astype(jnp.float32)
        s_blk = jnp.where(jnp.arange(nb) < own, s_blk, -jnp.inf)
        _, sel = lax.top_k(s_blk, top_k)
        sel_valid = sel < own
        k_sel = gather_blocks(k_blk, sel)
        v_sel = gather_blocks(v_blk, sel)
        logit_sel = jnp.einsum('bhqd,bhqkld->bhqkl', qc, k_sel).astype(jnp.float32) * scale
        logit_sel = jnp.where(sel_valid[..., None], logit_sel, NEG_INF)
        k_own = lax.dynamic_index_in_dim(k_blk, own, axis=2, keepdims=False)
        v_own = lax.dynamic_index_in_dim(v_blk, own, axis=2, keepdims=False)
        logit_own = jnp.einsum('bhqd,bhld->bhql', qc, k_own).astype(jnp.float32) * scale
        k_pos_own = own * MOBA_BLOCK + jnp.arange(MOBA_BLOCK)
        logit_own = jnp.where(k_pos_own[None, :] <= q_pos[:, None], logit_own, NEG_INF)
        n_sel = top_k * MOBA_BLOCK
        logits = jnp.concatenate(
            [logit_sel.reshape(B, H, QUERY_CHUNK, n_sel), logit_own], axis=-1)
        p = jax.nn.softmax(logits, axis=-1).astype(v.dtype)
        p_sel = p[..., :n_sel].reshape(B, H, QUERY_CHUNK, top_k, MOBA_BLOCK)
        p_own = p[..., n_sel:]
        return (jnp.einsum('bhqkl,bhqkld->bhqd', p_sel, v_sel)
                + jnp.einsum('bhql,bhld->bhqd', p_own, v_own))

    outs = lax.map(chunk, jnp.arange(n_chunks))
    return outs.transpose(1, 2, 0, 3, 4).reshape(B, H, S, Dh)


def multiscale_pool_mixer(u, w_pool, pool_scale):
    B, S, _ = u.shape
    ug = u.reshape(B, S, POOL_GROUPS, POOL_GROUP_DIM).astype(jnp.float32)
    cs = jnp.cumsum(ug, axis=1)
    t = jnp.arange(S, dtype=jnp.float32)[None, :, None]
    groups = []
    for g, w in enumerate(POOL_WINDOWS):
        c = cs[:, :, g]
        c_prev = jnp.pad(c, ((0, 0), (w, 0), (0, 0)))[:, :S]
        count = jnp.minimum(t + 1.0, float(w))
        groups.append((c - c_prev) / count - ug[:, :, g])
    pooled = jnp.stack(groups, axis=2).astype(u.dtype)
    mixed = jnp.einsum('bsgc,gcd->bsgd', pooled, w_pool)
    return mixed.reshape(B, S, POOL_WIDTH) * pool_scale


def causal_depthwise_conv(u, w, b):
    S = u.shape[1]
    kw = w.shape[0]
    up = jnp.pad(u, ((0, 0), (kw - 1, 0), (0, 0)))
    out = up[:, 0:S] * w[0]
    for j in range(1, kw):
        out = out + up[:, j:j + S] * w[j]
    return out + b


def hybrid_layer(x, norm_mix_g, w_in, b_gate, q_norm_g, k_norm_g, w_pool, pool_scale,
                 w_branch_attn, w_branch_pool, w_out, norm_ffn_g, w_up, conv_w, conv_b, w_down):
    B, S, D = x.shape
    h = rmsnorm(x, norm_mix_g)
    proj = h @ w_in
    q, k, v, u_pool, gate_logits = jnp.split(
        proj, [ATTN_WIDTH, 2 * ATTN_WIDTH, 3 * ATTN_WIDTH, 3 * ATTN_WIDTH + POOL_WIDTH], axis=-1)

    def heads(t):
        return t.reshape(B, S, ATTN_HEADS, HEAD_DIM).transpose(0, 2, 1, 3)

    pos = jnp.arange(S)
    q = apply_partial_rotary(rmsnorm(heads(q), q_norm_g), pos)
    k = apply_partial_rotary(rmsnorm(heads(k), k_norm_g), pos)
    attn = moba_attention(q, k, heads(v)).transpose(0, 2, 1, 3).reshape(B, S, ATTN_WIDTH)
    pooled = multiscale_pool_mixer(u_pool, w_pool, pool_scale)

    gates = jax.nn.sigmoid(gate_logits + b_gate).reshape(B, S, N_BRANCHES, D)
    mixed = gates[:, :, 0] * (attn @ w_branch_attn) + gates[:, :, 1] * (pooled @ w_branch_pool)
    x = x + mixed @ w_out

    h2 = rmsnorm(x, norm_ffn_g)
    up = causal_depthwise_conv(h2 @ w_up, conv_w, conv_b)
    gate, val = jnp.split(up, 2, axis=-1)
    return x + (jax.nn.silu(gate) * val) @ w_down


def setup_inputs(seed: int = 0) -> dict:
    key = jax.random.key(seed)
    ks = jax.random.split(key, 17)
    L = DEPTH
    f32 = jnp.float32

    def nrm(k, shape, scale):
        return jax.random.normal(k, shape, f32) * scale

    return {
        "x": nrm(ks[0], (BATCH, SEQ, D_MODEL), 1.0),
        "norm_mix_g": 1.0 + nrm(ks[1], (L, D_MODEL), 0.02),
        "w_in": nrm(ks[2], (L, D_MODEL, IN_WIDTH), D_MODEL ** -0.5),
        "b_gate": nrm(ks[3], (L, N_BRANCHES * D_MODEL), 0.1),
        "q_norm_g": 1.0 + nrm(ks[4], (L, HEAD_DIM), 0.02),
        "k_norm_g": 1.0 + nrm(ks[5], (L, HEAD_DIM), 0.02),
        "w_pool": nrm(ks[6], (L, POOL_GROUPS, POOL_GROUP_DIM, POOL_GROUP_DIM), POOL_GROUP_DIM ** -0.5),
        "pool_scale": 1.0 + nrm(ks[7], (L, POOL_WIDTH), 0.1),
        "w_branch_attn": nrm(ks[8], (L, ATTN_WIDTH, D_MODEL), ATTN_WIDTH ** -0.5),
        "w_branch_pool": nrm(ks[9], (L, POOL_WIDTH, D_MODEL), POOL_WIDTH ** -0.5),
        "w_out": nrm(ks[10], (L, D_MODEL, D_MODEL), D_MODEL ** -0.5),
        "norm_ffn_g": 1.0 + nrm(ks[11], (L, D_MODEL), 0.02),
        "w_up": nrm(ks[12], (L, D_MODEL, 2 * D_FF), D_MODEL ** -0.5),
        "conv_w": nrm(ks[13], (L, CONV_WIDTH, 2 * D_FF), CONV_WIDTH ** -0.5),
        "conv_b": nrm(ks[14], (L, 2 * D_FF), 0.02),
        "w_down": nrm(ks[15], (L, D_FF, D_MODEL), D_FF ** -0.5),
    }


def reference(x, norm_mix_g, w_in, b_gate, q_norm_g, k_norm_g, w_pool, pool_scale,
              w_branch_attn, w_branch_pool, w_out, norm_ffn_g, w_up, conv_w, conv_b, w_down):
    for l in range(DEPTH):
        x = hybrid_layer(x, norm_mix_g[l], w_in[l], b_gate[l], q_norm_g[l], k_norm_g[l],
                         w_pool[l], pool_scale[l], w_branch_attn[l], w_branch_pool[l], w_out[l],
                         norm_ffn_g[l], w_up[l], conv_w[l], conv_b[l], w_down[l])
    return x
```

```cpp
#include <hip/hip_runtime.h>
#include <hip/hip_cooperative_groups.h>
#include <cstdio>
namespace cg = cooperative_groups;

#define LAS __attribute__((address_space(3)))
typedef unsigned short bf16_t;
typedef short bf16x8 __attribute__((ext_vector_type(8)));
typedef short s16x4 __attribute__((ext_vector_type(4)));
typedef float f32x4 __attribute__((ext_vector_type(4)));
typedef float f32x16 __attribute__((ext_vector_type(16)));
typedef unsigned u32x4 __attribute__((ext_vector_type(4)));
typedef unsigned u32x2 __attribute__((ext_vector_type(2)));

constexpr int T = 32768, DM = 1024, SEQ = 8192, NH = 8, DH = 64, NBLK = 32, FF = 2816, FF2 = 5632, INW = 4096;
constexpr float EPS = 1e-6f;
constexpr size_t MiB = 1024 * 1024;
constexpr size_t WS_WIN = 0;
constexpr size_t WS_W2 = 8 * MiB;
constexpr size_t WS_WO = 10 * MiB;
constexpr size_t WS_WUP = 12 * MiB;
constexpr size_t WS_WD = 23 * MiB;
constexpr size_t WS_CS = 29 * MiB;
constexpr size_t WS_KMP = 29 * MiB + 512 * 1024;
constexpr size_t WS_BAR = 31 * MiB;
constexpr size_t WS_A = 32 * MiB;
constexpr size_t WS_Q = WS_A, WS_K = WS_A + 32 * MiB, WS_VT = WS_A + 64 * MiB, WS_U = WS_A + 96 * MiB, WS_AP = WS_A + 128 * MiB;
constexpr size_t WS_ACT = WS_A;
constexpr size_t WS_B = WS_A + 192 * MiB;
constexpr size_t WS_C = WS_B + 64 * MiB;
constexpr size_t WS_D = WS_C + 64 * MiB;
constexpr size_t WS_HALO = WS_D, WS_SSQ = WS_D + 24 * MiB;
constexpr size_t WS_END = WS_D + 64 * MiB;
constexpr int LDS_BYTES = 147456 + 64;

struct Params {
    const float *x, *norm_mix_g, *w_in, *b_gate, *q_norm_g, *k_norm_g, *w_pool, *pool_scale, *w_ba, *w_bp, *w_out, *norm_ffn_g, *w_up, *conv_w, *conv_b, *w_down;
    float* out; unsigned char* ws; int ph_lo, ph_hi;
};

__device__ __forceinline__ unsigned cvt_pk_bf16(float lo, float hi) { unsigned r; asm volatile("v_cvt_pk_bf16_f32 %0, %1, %2" : "=v"(r) : "v"(lo), "v"(hi)); return r; }
__device__ __forceinline__ float bf2f(unsigned short b) { return __uint_as_float(((unsigned)b) << 16); }
__device__ __forceinline__ float bflo(unsigned w) { return __uint_as_float(w << 16); }
__device__ __forceinline__ float bfhi(unsigned w) { return __uint_as_float(w & 0xffff0000u); }

namespace pg8 {
constexpr int BM = 256, BK = 64, HALF = 128, HTB = HALF * BK * 2, STAGE_BYTES = 8 * HTB, NXCD = 8, WGM = 8;
__host__ __device__ __forceinline__ int lds_byte(int r, int c) { const int st = (r >> 4) * 2 + (c >> 5), rr = r & 15, cc = c & 31, ob = rr * 64 + cc * 2; return st * 1024 + (ob ^ (((ob >> 9) & 1) << 5)); }
__host__ __device__ __forceinline__ void stage_rc(int b, int& R, int& C) { const int st = b / 1024, sb = b % 1024, swz = sb ^ (((sb >> 9) & 1) << 5); R = (st >> 1) * 16 + swz / 64; C = (st & 1) * 32 + (swz % 64) / 2; }
__host__ __device__ __forceinline__ int perm32(int rho) { const int n = rho >> 4, i = rho & 15; return 8 * (i >> 2) + 4 * n + (i & 3); }
struct Unit { int pm, pn; };
struct Gemm { const bf16_t* A; const bf16_t* Bt; int M, N, K; };
struct StaticOrder {
    int nM, nN, nwg, G, c;
    __host__ __device__ void init(int M, int N, int G_, int c_) { nM = M / BM; nN = N / BM; nwg = nM * nN; G = G_; c = c_; }
    __host__ __device__ bool next(int i, Unit& u) const {
        const long L = (long)i * G + c; if (L >= nwg) return false;
        int wgid = (int)L; { const int q = nwg / NXCD, r = nwg % NXCD, xcd = wgid % NXCD, off = wgid / NXCD; wgid = (xcd < r ? xcd * (q + 1) : r * (q + 1) + (xcd - r) * q) + off; }
        const int nig = WGM * nN, gid = wgid / nig, fm = gid * WGM, gsz = (nM - fm) < WGM ? (nM - fm) : WGM;
        u.pm = fm + ((wgid % nig) % gsz); u.pn = (wgid % nig) / gsz; return true;
    }
};

template <class Epi>
__device__ __forceinline__ void gemm_phase(LAS unsigned char* lds, const Gemm g, const StaticOrder& S, const Epi& E) {
    const int tid = threadIdx.x, wid = __builtin_amdgcn_readfirstlane(tid >> 6), lane = tid & 63, wr = wid >> 2, wc = wid & 3, fr = lane & 15, fq = lane >> 4;
    const int K = g.K, nt = K / BK;
    unsigned voffA[2], voffB[2];
#pragma unroll
    for (int i = 0; i < 2; ++i) { int R, C; stage_rc(tid * 16 + i * 8192, R, C); const int Rb = Epi::PERM ? ((R & ~31) + perm32(R & 31)) : R;
        const int Ra = Epi::APERM ? (8 * (16 * (R >> 6) + (R & 15)) + ((R >> 4) & 3)) : R;
        voffA[i] = (unsigned)(Ra * K + C) * 2u; voffB[i] = (unsigned)(Rb * K + C) * 2u; }
    const size_t kstep = (size_t)(BK * 2);
    const size_t hstep = (size_t)HALF * K * 2;
    const size_t hstepA = Epi::APERM ? (size_t)4 * K * 2 : hstep;
    const size_t tstep = 2 * hstep;
    const unsigned ldsw = (unsigned)wid * 1024u;
    const int aoff = lds_byte(wr * 64 + fr, fq * 8), boff = lds_byte(wc * 32 + fr, fq * 8);
#define PG8_SA(b, h) (((b) * 2 + (h)) * HTB)
#define PG8_SB(b, h) ((4 + (b) * 2 + (h)) * HTB)
#define PG8_STAGE(bufoff, gbase, voff) do { _Pragma("unroll") for (int _i = 0; _i < 2; ++_i) \
        __builtin_amdgcn_global_load_lds((const unsigned*)((const char*)(gbase) + (voff)[_i]), (LAS unsigned*)(lds + (bufoff) + ldsw + _i * 8192), 16, 0, 0); } while (0)
#define PG8_LDA(dst, b, h) do { _Pragma("unroll") for (int m = 0; m < 4; ++m) _Pragma("unroll") for (int k = 0; k < 2; ++k) dst[m][k] = *(const LAS bf16x8*)(lds + PG8_SA(b, h) + aoff + m * 2048 + k * 1024); } while (0)
#define PG8_LDB(dst, b, h) do { _Pragma("unroll") for (int n = 0; n < 2; ++n) _Pragma("unroll") for (int k = 0; k < 2; ++k) dst[n][k] = *(const LAS bf16x8*)(lds + PG8_SB(b, h) + boff + n * 2048 + k * 1024); } while (0)
#define PG8_MMA(ai, bj, At, Bt) do { __builtin_amdgcn_s_setprio(1); _Pragma("unroll") for (int m = 0; m < 4; ++m) _Pragma("unroll") for (int n = 0; n < 2; ++n) _Pragma("unroll") for (int k = 0; k < 2; ++k) \
        acc[ai][bj][m][n] = __builtin_amdgcn_mfma_f32_16x16x32_bf16(Bt[n][k], At[m][k], acc[ai][bj][m][n], 0, 0, 0); __builtin_amdgcn_s_setprio(0); } while (0)
#define PG8_WAIT_V(n) asm volatile("s_waitcnt vmcnt(" #n ")" ::: "memory")
#define PG8_WAIT_L(n) asm volatile("s_waitcnt lgkmcnt(" #n ")" ::: "memory")
#define PG8_BAR __builtin_amdgcn_s_barrier()
#define PG8_SCHED __builtin_amdgcn_sched_barrier(0)
    Unit cur, nxt; int ui = 0;
    if (!S.next(0, cur)) return;
    f32x4 acc[2][2][4][2];
#pragma unroll
    for (int a = 0; a < 2; ++a)
#pragma unroll
        for (int b = 0; b < 2; ++b)
#pragma unroll
            for (int m = 0; m < 4; ++m)
#pragma unroll
                for (int n = 0; n < 2; ++n) acc[a][b][m][n] = (f32x4){0.f, 0.f, 0.f, 0.f};
    bf16x8 At[4][2], B0[2][2], B1[2][2];
    const char* cA = (const char*)g.A + (size_t)cur.pm * tstep; const char* cB = (const char*)g.Bt + (size_t)cur.pn * tstep;
    PG8_STAGE(PG8_SB(0, 0), cB, voffB); PG8_STAGE(PG8_SB(0, 1), cB + hstep, voffB); PG8_STAGE(PG8_SA(0, 0), cA, voffA); PG8_STAGE(PG8_SA(0, 1), cA + hstepA, voffA);
    if (wr == 1) PG8_BAR;
    PG8_WAIT_V(2); PG8_BAR;
    PG8_STAGE(PG8_SB(1, 0), cB + kstep, voffB); PG8_STAGE(PG8_SA(1, 0), cA + kstep, voffA); PG8_STAGE(PG8_SB(1, 1), cB + hstep + kstep, voffB);
    PG8_WAIT_V(6); PG8_BAR;
    for (;;) {
        const bool has_next = S.next(ui + 1, nxt);
        const char* nA = has_next ? (const char*)g.A + (size_t)nxt.pm * tstep : cA; const char* nB = has_next ? (const char*)g.Bt + (size_t)nxt.pn * tstep : cB;
        for (int t = 0; t < nt; t += 2) {
            const bool last = (t == nt - 2);
            const char* a1 = cA + (size_t)(t + 1) * kstep;
            const char* a2 = last ? nA : cA + (size_t)(t + 2) * kstep; const char* b2 = last ? nB : cB + (size_t)(t + 2) * kstep;
            const char* a3 = a2 + kstep; const char* b3 = b2 + kstep;
            if constexpr (Epi::MID) { if (t == Epi::MID_T) E.mid(acc, cur, wr, wc, fr, fq); }
            if constexpr (Epi::PRE) { if (last) E.pre(cur, wr, wc, lane); }
            PG8_LDB(B0, 0, 0); PG8_LDB(B1, 0, 1); PG8_SCHED; PG8_LDA(At, 0, 0); PG8_STAGE(PG8_SA(1, 1), a1 + hstepA, voffA);
            PG8_WAIT_V(8); PG8_WAIT_L(0); PG8_BAR; PG8_MMA(0, 0, At, B0); PG8_MMA(0, 1, At, B1); PG8_BAR; PG8_SCHED;
            PG8_LDA(At, 0, 1); PG8_STAGE(PG8_SB(0, 0), b2, voffB); PG8_STAGE(PG8_SB(0, 1), b2 + hstep, voffB); PG8_STAGE(PG8_SA(0, 0), a2, voffA);
            PG8_WAIT_V(8); PG8_WAIT_L(0); PG8_BAR; PG8_MMA(1, 0, At, B0); PG8_MMA(1, 1, At, B1); PG8_BAR; PG8_SCHED;
            PG8_LDB(B0, 1, 0); PG8_LDB(B1, 1, 1); PG8_SCHED; PG8_LDA(At, 1, 0); PG8_STAGE(PG8_SA(0, 1), a2 + hstepA, voffA);
            PG8_WAIT_V(8); PG8_WAIT_L(0); PG8_BAR; PG8_MMA(0, 0, At, B0); PG8_MMA(0, 1, At, B1); PG8_BAR; PG8_SCHED;
            PG8_LDA(At, 1, 1); PG8_STAGE(PG8_SB(1, 0), b3, voffB); PG8_STAGE(PG8_SB(1, 1), b3 + hstep, voffB); PG8_STAGE(PG8_SA(1, 0), a3, voffA);
            PG8_WAIT_V(8); PG8_WAIT_L(0); PG8_BAR; PG8_MMA(1, 0, At, B0); PG8_MMA(1, 1, At, B1); PG8_BAR; PG8_SCHED;
        }
        if (wr == 0) PG8_BAR;
        E(acc, cur, wr, wc, fr, fq);
        if (!has_next) break;
#pragma unroll
        for (int a = 0; a < 2; ++a)
#pragma unroll
            for (int b = 0; b < 2; ++b)
#pragma unroll
                for (int m = 0; m < 4; ++m)
#pragma unroll
                    for (int n = 0; n < 2; ++n) acc[a][b][m][n] = (f32x4){0.f, 0.f, 0.f, 0.f};
        cur = nxt; cA = nA; cB = nB; ++ui;
        if (wr == 1) PG8_BAR;
    }
    PG8_WAIT_V(0);
    PG8_BAR;
#undef PG8_SA
#undef PG8_SB
#undef PG8_STAGE
#undef PG8_LDA
#undef PG8_LDB
#undef PG8_MMA
#undef PG8_WAIT_V
#undef PG8_WAIT_L
#undef PG8_BAR
#undef PG8_SCHED
}
}
using pg8::Unit;

struct EpiG1 {
    static constexpr bool PERM = true, APERM = true, MID = false, PRE = false; static constexpr int MID_T = -1;
    bf16_t *q, *k, *vt, *u, *R, *G1v; float* kmp; const float *qg, *kg, *bgate; const float2* cs;
    __device__ __forceinline__ void operator()(const f32x4 (&acc)[2][2][4][2], const Unit& un, int wr, int wc, int fr, int fq) const {
        const int pn = un.pn, pm = un.pm;
        const int g8 = (16 * wr + fr) * 8, tok0 = pm * 256 + g8, b = pm >> 5, blk = pm & 31, pos0 = (blk << 8) + g8;
        if (pn < 4) {
            const bool isk = pn >= 2; const int hd = (pn & 1) * 4 + wc; const float* gw = isk ? kg : qg; const float sc = isk ? 1.f : 0.125f * 1.4426950408889634f;
            f32x4 gv[2][2], ks[2][2];
#pragma unroll
            for (int bj = 0; bj < 2; ++bj)
#pragma unroll
                for (int n = 0; n < 2; ++n) { gv[bj][n] = *(const f32x4*)(gw + 32 * bj + 8 * fq + 4 * n) * sc; ks[bj][n] = (f32x4){0.f, 0.f, 0.f, 0.f}; }
            float2 cb0[2][4];
#pragma unroll
            for (int n = 0; n < 2; ++n)
#pragma unroll
                for (int e = 0; e < 4; ++e) cb0[n][e] = cs[(size_t)pos0 * 8 + 4 * n + e];
            bf16_t* dst = (isk ? k : q) + ((size_t)(b * 8 + hd) * SEQ + pos0) * 64 + 8 * fq;
            bf16_t* dstk = k + ((size_t)(b * 8 + hd) * SEQ + (size_t)blk * 256) * 64 + (fq >> 1) * 512 + (fq & 1) * 256;
#pragma unroll
            for (int ai = 0; ai < 2; ++ai)
#pragma unroll
                for (int m = 0; m < 4; ++m) {
                    const int slot = 4 * ai + m;
                    float ss = 0.f;
#pragma unroll
                    for (int bj = 0; bj < 2; ++bj)
#pragma unroll
                        for (int n = 0; n < 2; ++n) { const f32x4 v = acc[ai][bj][m][n]; ss += (v[0] * v[0] + v[1] * v[1]) + (v[2] * v[2] + v[3] * v[3]); }
                    ss += __shfl_xor(ss, 16); ss += __shfl_xor(ss, 32);
                    const float rs = rsqrtf(ss * (1.0f / 64.0f) + EPS);
                    f32x4 y[2][2];
#pragma unroll
                    for (int bj = 0; bj < 2; ++bj)
#pragma unroll
                        for (int n = 0; n < 2; ++n) y[bj][n] = acc[ai][bj][m][n] * rs * gv[bj][n];
#pragma unroll
                    for (int n = 0; n < 2; ++n)
#pragma unroll
                        for (int e = 0; e < 4; ++e) {
                            const float2 d = cs[slot * 8 + 4 * n + e], b0 = cb0[n][e]; const float2 c = make_float2(b0.x * d.x - b0.y * d.y, b0.y * d.x + b0.x * d.y);
                            const float own = y[0][n][e], oth = __shfl_xor(own, 16);
                            const float r = (fq == 0) ? (own * c.x - oth * c.y) : (own * c.x + oth * c.y);
                            y[0][n][e] = (fq < 2) ? r : own;
                        }
                    if (isk) {
#pragma unroll
                        for (int bj = 0; bj < 2; ++bj)
#pragma unroll
                            for (int n = 0; n < 2; ++n) ks[bj][n] += y[bj][n];
                    }
#pragma unroll
                    for (int bj = 0; bj < 2; ++bj) { u32x4 w; w.x = cvt_pk_bf16(y[bj][0][0], y[bj][0][1]); w.y = cvt_pk_bf16(y[bj][0][2], y[bj][0][3]); w.z = cvt_pk_bf16(y[bj][1][0], y[bj][1][1]); w.w = cvt_pk_bf16(y[bj][1][2], y[bj][1][3]);
                        if (isk) { const int key = g8 + slot; *(u32x4*)(dstk + (key >> 5) * 2048 + bj * 1024 + (key & 31) * 8) = w; }
                        else *(u32x4*)(dst + slot * 64 + 32 * bj) = w; }
                }
            if (isk) {
#pragma unroll
                for (int bj = 0; bj < 2; ++bj)
#pragma unroll
                    for (int n = 0; n < 2; ++n)
#pragma unroll
                        for (int e = 0; e < 4; ++e) { float v = ks[bj][n][e]; v += __shfl_xor(v, 1); v += __shfl_xor(v, 2); v += __shfl_xor(v, 4); v += __shfl_xor(v, 8); ks[bj][n][e] = v; }
                if (fr == 0) { float* kd = kmp + ((size_t)(((b * 32 + blk) * 8 + hd) * 2 + wr)) * 64 + 8 * fq;
#pragma unroll
                    for (int bj = 0; bj < 2; ++bj)
#pragma unroll
                        for (int n = 0; n < 2; ++n) *(f32x4*)(kd + 32 * bj + 4 * n) = ks[bj][n]; }
            }
        } else if (pn < 6) {
            const int hd = (pn & 1) * 4 + wc; const int g = 16 * wr + fr;
            bf16_t* dst = vt + ((size_t)(b * 8 + hd) * SEQ + (size_t)blk * 256) * 64 + (g >> 2) * 2048 + ((g >> 1) & 1) * 512 + (8 * fq) * 8 + 4 * (g & 1);
#pragma unroll
            for (int bj = 0; bj < 2; ++bj)
#pragma unroll
                for (int n = 0; n < 2; ++n)
#pragma unroll
                    for (int e = 0; e < 4; ++e)
#pragma unroll
                        for (int ai = 0; ai < 2; ++ai) { u32x2 w;
                            w.x = cvt_pk_bf16(acc[ai][bj][0][n][e], acc[ai][bj][1][n][e]); w.y = cvt_pk_bf16(acc[ai][bj][2][n][e], acc[ai][bj][3][n][e]);
                            *(u32x2*)(dst + bj * 1024 + ai * 256 + (4 * n + e) * 8) = w; }
        } else if (pn < 8) {
            bf16_t* dst = u + (size_t)tok0 * 512 + 256 * (pn - 6) + 32 * wc + 8 * fq;
#pragma unroll
            for (int ai = 0; ai < 2; ++ai)
#pragma unroll
                for (int m = 0; m < 4; ++m)
#pragma unroll
                    for (int bj = 0; bj < 2; ++bj) { const f32x4 v0 = acc[ai][bj][m][0], v1 = acc[ai][bj][m][1]; u32x4 w;
                        w.x = cvt_pk_bf16(v0[0], v0[1]); w.y = cvt_pk_bf16(v0[2], v0[3]); w.z = cvt_pk_bf16(v1[0], v1[1]); w.w = cvt_pk_bf16(v1[2], v1[3]);
                        *(u32x4*)(dst + (size_t)(4 * ai + m) * 512 + 128 * bj) = w; }
        } else {
            const int d0 = 128 * (pn - 8) + 32 * wc + 8 * fq;
            f32x4 ba[2], bb[2];
#pragma unroll
            for (int n = 0; n < 2; ++n) { ba[n] = *(const f32x4*)(bgate + d0 + 4 * n); bb[n] = *(const f32x4*)(bgate + 1024 + d0 + 4 * n); }
#pragma unroll
            for (int ai = 0; ai < 2; ++ai)
#pragma unroll
                for (int m = 0; m < 4; ++m) {
                    float rr[8], gg[8];
#pragma unroll
                    for (int n = 0; n < 2; ++n)
#pragma unroll
                        for (int e = 0; e < 4; ++e) { const float a = acc[ai][0][m][n][e] + ba[n][e], bq = acc[ai][1][m][n][e] + bb[n][e];
                            const float pa = 1.f + __builtin_amdgcn_exp2f(a * -1.4426950408889634f), pb = 1.f + __builtin_amdgcn_exp2f(bq * -1.4426950408889634f);
                            const float t = __builtin_amdgcn_rcpf(pa * pb);
                            rr[4 * n + e] = pb * pb * t; gg[4 * n + e] = t * pa; }
                    u32x4 w1, w2;
                    w1.x = cvt_pk_bf16(rr[0], rr[1]); w1.y = cvt_pk_bf16(rr[2], rr[3]); w1.z = cvt_pk_bf16(rr[4], rr[5]); w1.w = cvt_pk_bf16(rr[6], rr[7]);
                    w2.x = cvt_pk_bf16(gg[0], gg[1]); w2.y = cvt_pk_bf16(gg[2], gg[3]); w2.z = cvt_pk_bf16(gg[4], gg[5]); w2.w = cvt_pk_bf16(gg[6], gg[7]);
                    const size_t o = (size_t)(tok0 + 4 * ai + m) * 1024 + d0;
                    *(u32x4*)(R + o) = w1; *(u32x4*)(G1v + o) = w2;
                }
        }
    }
};

struct EpiG2 {
    static constexpr bool PERM = true, APERM = false, MID = true, PRE = false; static constexpr int MID_T = 8;
    const bf16_t *R, *G1v; bf16_t* mixed;
    __device__ __forceinline__ void mid(f32x4 (&acc)[2][2][4][2], const Unit& un, int wr, int wc, int fr, int fq) const {
        unsigned lo_ = (unsigned)((wr * 64 + fr) * 1024 + 32 * wc + 8 * fq); asm volatile("" : "+v"(lo_));
        const bf16_t* src = R + (size_t)(un.pm * 256) * 1024 + un.pn * 256 + lo_;
#pragma unroll
        for (int ai = 0; ai < 2; ++ai) {
            u32x4 w[4][2];
#pragma unroll
            for (int m = 0; m < 4; ++m)
#pragma unroll
                for (int bj = 0; bj < 2; ++bj) w[m][bj] = *(const u32x4*)(src + (size_t)(128 * ai + 16 * m) * 1024 + 128 * bj);
#pragma unroll
            for (int m = 0; m < 4; ++m)
#pragma unroll
                for (int bj = 0; bj < 2; ++bj) { const u32x4 v = w[m][bj];
                    acc[ai][bj][m][0] *= (f32x4){bflo(v.x), bfhi(v.x), bflo(v.y), bfhi(v.y)}; acc[ai][bj][m][1] *= (f32x4){bflo(v.z), bfhi(v.z), bflo(v.w), bfhi(v.w)}; }
            asm volatile("" : "+v"(acc[ai][0][0][0]), "+v"(acc[ai][0][0][1]), "+v"(acc[ai][1][0][0]), "+v"(acc[ai][1][0][1]), "+v"(acc[ai][0][1][0]), "+v"(acc[ai][0][1][1]), "+v"(acc[ai][1][1][0]), "+v"(acc[ai][1][1][1]) :: "memory");
            asm volatile("" : "+v"(acc[ai][0][2][0]), "+v"(acc[ai][0][2][1]), "+v"(acc[ai][1][2][0]), "+v"(acc[ai][1][2][1]), "+v"(acc[ai][0][3][0]), "+v"(acc[ai][0][3][1]), "+v"(acc[ai][1][3][0]), "+v"(acc[ai][1][3][1]) :: "memory");
        }
    }
    __device__ __forceinline__ void operator()(const f32x4 (&acc)[2][2][4][2], const Unit& un, int wr, int wc, int fr, int fq) const {
        const size_t o0 = (size_t)(un.pm * 256 + wr * 64 + fr) * 1024 + un.pn * 256 + 32 * wc + 8 * fq;
#pragma unroll
        for (int ai = 0; ai < 2; ++ai) {
            u32x4 gw[4][2];
#pragma unroll
            for (int m = 0; m < 4; ++m)
#pragma unroll
                for (int bj = 0; bj < 2; ++bj) gw[m][bj] = *(const u32x4*)(G1v + o0 + (size_t)(128 * ai + 16 * m) * 1024 + 128 * bj);
#pragma unroll
            for (int m = 0; m < 4; ++m)
#pragma unroll
                for (int bj = 0; bj < 2; ++bj) { const size_t o = o0 + (size_t)(128 * ai + 16 * m) * 1024 + 128 * bj; const u32x4 w = gw[m][bj];
                    const f32x4 v0 = acc[ai][bj][m][0] * (f32x4){bflo(w.x), bfhi(w.x), bflo(w.y), bfhi(w.y)}, v1 = acc[ai][bj][m][1] * (f32x4){bflo(w.z), bfhi(w.z), bflo(w.w), bfhi(w.w)};
                    u32x4 r; r.x = cvt_pk_bf16(v0[0], v0[1]); r.y = cvt_pk_bf16(v0[2], v0[3]); r.z = cvt_pk_bf16(v1[0], v1[1]); r.w = cvt_pk_bf16(v1[2], v1[3]);
                    *(u32x4*)(mixed + o) = r; }
            asm volatile("" ::: "memory");
        }
    }
};

struct EpiG3 {
    static constexpr bool PERM = true, APERM = false, MID = false, PRE = false; static constexpr int MID_T = -1;
    const float* x; bf16_t* x1b; float* ssq;
    __device__ __forceinline__ void operator()(const f32x4 (&acc)[2][2][4][2], const Unit& un, int wr, int wc, int fr, int fq) const {
        const int row0 = un.pm * 256 + wr * 64 + fr; const int col0 = un.pn * 256 + 32 * wc + 8 * fq;
#pragma unroll
        for (int ai = 0; ai < 2; ++ai)
#pragma unroll
            for (int mh = 0; mh < 2; ++mh) {
                f32x4 xv[2][2][2];
#pragma unroll
                for (int m2 = 0; m2 < 2; ++m2)
#pragma unroll
                    for (int bj = 0; bj < 2; ++bj) { const size_t o = (size_t)(row0 + 128 * ai + 16 * (2 * mh + m2)) * 1024 + col0 + 128 * bj; xv[m2][bj][0] = __builtin_nontemporal_load((const f32x4*)(x + o)); xv[m2][bj][1] = __builtin_nontemporal_load((const f32x4*)(x + o + 4)); }
#pragma unroll
                for (int m2 = 0; m2 < 2; ++m2) { const int m = 2 * mh + m2; const int row = row0 + 128 * ai + 16 * m; float ss = 0.f;
#pragma unroll
                    for (int bj = 0; bj < 2; ++bj) { const size_t o = (size_t)row * 1024 + col0 + 128 * bj;
                        const f32x4 v0 = acc[ai][bj][m][0] + xv[m2][bj][0], v1 = acc[ai][bj][m][1] + xv[m2][bj][1];
                        u32x4 r; r.x = cvt_pk_bf16(v0[0], v0[1]); r.y = cvt_pk_bf16(v0[2], v0[3]); r.z = cvt_pk_bf16(v1[0], v1[1]); r.w = cvt_pk_bf16(v1[2], v1[3]);
                        *(u32x4*)(x1b + o) = r;
                        ss += (v0[0] * v0[0] + v0[1] * v0[1]) + (v0[2] * v0[2] + v0[3] * v0[3]) + (v1[0] * v1[0] + v1[1] * v1[1]) + (v1[2] * v1[2] + v1[3] * v1[3]); }
                    ss += __shfl_xor(ss, 16); ss += __shfl_xor(ss, 32);
                    if (fq == 0) ssq[(size_t)row * 16 + un.pn * 4 + wc] = ss; }
                asm volatile("" ::: "memory");
            }
    }
};

struct EpiG4 {
    static constexpr bool PERM = true, APERM = true, MID = false, PRE = true; static constexpr int MID_T = -1;
    const float *ssq, *cw, *cb; bf16_t* act; float* halo; LAS float* wl;
    __device__ __forceinline__ void pre(const Unit& un, int wr, int wc, int lane) const {
        LAS float* pw = wl + (wr * 4 + wc) * 400 + 128;
        const int c0 = 128 * un.pn + 32 * wc, a = lane >> 3, cc = 4 * (lane & 7); const float* pp = ((a & 3) == 3 ? cb : cw + (size_t)(a & 3) * FF2) + (a >> 2) * FF + c0 + cc;
        __builtin_amdgcn_global_load_lds((const unsigned*)pp, (LAS unsigned*)pw, 16, 0, 0);
    }
    __device__ __forceinline__ void operator()(f32x4 (&acc)[2][2][4][2], const Unit& un, int wr, int wc, int fr, int fq) const {
        const int lane = fr + 16 * fq;
        LAS float* rsl = wl + (wr * 4 + wc) * 400;
        LAS float* pw = rsl + 128;
        LAS int* tag = (LAS int*)(rsl + 384);
        const int tokw = un.pm * 256 + 128 * wr, c0 = 128 * un.pn + 32 * wc;
        if (*tag != un.pm) {
            const f32x4* s0 = (const f32x4*)(ssq + (size_t)(tokw + lane) * 16); const f32x4* s1 = (const f32x4*)(ssq + (size_t)(tokw + 64 + lane) * 16);
            const f32x4 x0 = s0[0] + s0[1] + s0[2] + s0[3], x1 = s1[0] + s1[1] + s1[2] + s1[3];
            rsl[lane] = rsqrtf(((x0[0] + x0[1]) + (x0[2] + x0[3])) * (1.0f / 1024.0f) + EPS); rsl[64 + lane] = rsqrtf(((x1[0] + x1[1]) + (x1[2] + x1[3])) * (1.0f / 1024.0f) + EPS);
            if (lane == 0) *tag = un.pm;
        }
        asm volatile("s_waitcnt vmcnt(0)" ::: "memory");
        const int tok0 = un.pm * 256 + (16 * wr + fr) * 8, grp = un.pm * 2 + wr;
        {   const f32x4 r0 = *(const LAS f32x4*)(rsl + 8 * fr), r1 = *(const LAS f32x4*)(rsl + 8 * fr + 4);
#pragma unroll
            for (int s = 0; s < 8; ++s) { const float rs = (s < 4) ? r0[s & 3] : r1[s & 3];
#pragma unroll
                for (int bj = 0; bj < 2; ++bj)
#pragma unroll
                    for (int n = 0; n < 2; ++n) acc[s >> 2][bj][s & 3][n] *= rs; } }
#pragma unroll
        for (int n = 0; n < 2; ++n) {
            const int cg0 = c0 + 8 * fq + 4 * n;
            const int np0 = 256 * un.pn + 32 * wc + 8 * fq + 4 * n;
            typedef float f32x2 __attribute__((ext_vector_type(2)));
            unsigned pk[8][2];
#pragma unroll
            for (int ep = 0; ep < 2; ++ep) {
                f32x2 prm[8];
#pragma unroll
                for (int a = 0; a < 8; ++a) prm[a] = *(const LAS f32x2*)(pw + a * 32 + 8 * fq + 4 * n + 2 * ep);
                f32x2 ug[8], uv[8];
#pragma unroll
                for (int s = 0; s < 8; ++s) { ug[s] = (f32x2){acc[s >> 2][0][s & 3][n][2 * ep], acc[s >> 2][0][s & 3][n][2 * ep + 1]}; uv[s] = (f32x2){acc[s >> 2][1][s & 3][n][2 * ep], acc[s >> 2][1][s & 3][n][2 * ep + 1]}; }
                f32x2 pg1, pg2, pv1, pv2;
#pragma unroll
                for (int e2 = 0; e2 < 2; ++e2) {
                    pg1[e2] = __shfl_up(ug[7][e2], 1); pg2[e2] = __shfl_up(ug[6][e2], 1); pv1[e2] = __shfl_up(uv[7][e2], 1); pv2[e2] = __shfl_up(uv[6][e2], 1);
                }
                if (fr == 0) { float* h = halo + ((size_t)grp * 4) * FF2 + np0 + 2 * ep; *(f32x2*)h = ug[0]; *(f32x2*)(h + 128) = uv[0]; *(f32x2*)(h + FF2) = ug[1]; *(f32x2*)(h + FF2 + 128) = uv[1]; }
                if (fr == 15) { float* h = halo + ((size_t)grp * 4 + 2) * FF2 + np0 + 2 * ep; *(f32x2*)h = ug[6]; *(f32x2*)(h + 128) = uv[6]; *(f32x2*)(h + FF2) = ug[7]; *(f32x2*)(h + FF2 + 128) = uv[7]; }
#pragma unroll
                for (int s = 0; s < 8; ++s) {
                    const f32x2 g1 = (s >= 1) ? ug[s >= 1 ? s - 1 : 0] : pg1, v1 = (s >= 1) ? uv[s >= 1 ? s - 1 : 0] : pv1;
                    const f32x2 g2 = (s >= 2) ? ug[s >= 2 ? s - 2 : 0] : (s == 1 ? pg1 : pg2), v2 = (s >= 2) ? uv[s >= 2 ? s - 2 : 0] : (s == 1 ? pv1 : pv2);
                    const f32x2 cgv = prm[0] * g2 + prm[1] * g1 + prm[2] * ug[s] + prm[3];
                    const f32x2 cvv = prm[4] * v2 + prm[5] * v1 + prm[6] * uv[s] + prm[7];
                    const f32x2 ex = cgv * (-1.4426950408889634f);
                    f32x2 den; den[0] = 1.f + __builtin_amdgcn_exp2f(ex[0]); den[1] = 1.f + __builtin_amdgcn_exp2f(ex[1]);
                    f32x2 rc; rc[0] = __builtin_amdgcn_rcpf(den[0]); rc[1] = __builtin_amdgcn_rcpf(den[1]);
                    const f32x2 res = cgv * rc * cvv;
                    pk[s][ep] = cvt_pk_bf16(res[0], res[1]);
                }
            }
#pragma unroll
            for (int s = 0; s < 8; ++s) { u32x2 w; w.x = pk[s][0]; w.y = pk[s][1];
                if (s >= 2 || fr != 0) *(u32x2*)(act + (size_t)(tok0 + s) * FF + cg0) = w; }
        }
    }
};

struct EpiG5 {
    static constexpr bool PERM = true, APERM = false, MID = false, PRE = false; static constexpr int MID_T = -1;
    const bf16_t* x1b; float* out;
    __device__ __forceinline__ void operator()(const f32x4 (&acc)[2][2][4][2], const Unit& un, int wr, int wc, int fr, int fq) const {
        const size_t o0 = (size_t)(un.pm * 256 + wr * 64 + fr) * 1024 + un.pn * 256 + 32 * wc + 8 * fq;
#pragma unroll
        for (int ai = 0; ai < 2; ++ai) {
            u32x4 xr[4][2];
#pragma unroll
            for (int m = 0; m < 4; ++m)
#pragma unroll
                for (int bj = 0; bj < 2; ++bj) xr[m][bj] = *(const u32x4*)(x1b + o0 + (size_t)(128 * ai + 16 * m) * 1024 + 128 * bj);
#pragma unroll
            for (int m = 0; m < 4; ++m)
#pragma unroll
                for (int bj = 0; bj < 2; ++bj) { const size_t o = o0 + (size_t)(128 * ai + 16 * m) * 1024 + 128 * bj; const u32x4 w = xr[m][bj];
                    *(f32x4*)(out + o) = acc[ai][bj][m][0] + (f32x4){bflo(w.x), bfhi(w.x), bflo(w.y), bfhi(w.y)}; *(f32x4*)(out + o + 4) = acc[ai][bj][m][1] + (f32x4){bflo(w.z), bfhi(w.z), bflo(w.w), bfhi(w.w)}; }
            asm volatile("" ::: "memory");
        }
    }
};

template <bool AP_> struct EpiNull {
    static constexpr bool PERM = true, APERM = AP_, MID = false, PRE = false; static constexpr int MID_T = -1;
    float* sink;
    __device__ __forceinline__ void operator()(const f32x4 (&acc)[2][2][4][2], const Unit& un, int wr, int wc, int fr, int fq) const {
        float s = 0.f;
#pragma unroll
        for (int a = 0; a < 2; ++a)
#pragma unroll
            for (int b = 0; b < 2; ++b)
#pragma unroll
                for (int m = 0; m < 4; ++m)
#pragma unroll
                    for (int n = 0; n < 2; ++n) s += acc[a][b][m][n][0] + acc[a][b][m][n][1] + acc[a][b][m][n][2] + acc[a][b][m][n][3];
        if (s == 12345.678f) sink[0] = s;
    }
};
__device__ __forceinline__ int colmap_in(int np) {
    const int pn = np >> 8, p = np & 255;
    if (pn < 6) { const int bj = p >> 7, wc = (p >> 5) & 3, j = p & 31; return 256 * pn + 64 * wc + 32 * bj + j; }
    if (pn < 8) return np;
    return 2048 + 1024 * (p >> 7) + 128 * (pn - 8) + (p & 127);
}
__device__ __forceinline__ int colmap_up(int np) { const int pn = np >> 8, p = np & 255; return FF * (p >> 7) + 128 * pn + (p & 127); }

struct TrJob { const float* src; const float* scale; bf16_t* dst; int Nsrc, ldd, k0, n0, mode; };
__device__ __forceinline__ TrJob tr_decode(const Params& p, int t) {
    unsigned char* ws = p.ws; TrJob j;
    if (t < 1024) { j = TrJob{p.w_in, p.norm_mix_g, (bf16_t*)(ws + WS_WIN), INW, 1024, (t & 15) * 64, (t >> 4) * 64, 1}; }
    else if (t < 1152) { const int u = t - 1024; j = TrJob{p.w_ba, nullptr, (bf16_t*)(ws + WS_W2), 1024, 1024, (u & 7) * 64, (u >> 3) * 64, 0}; }
    else if (t < 1408) { const int u = t - 1152; j = TrJob{p.w_out, nullptr, (bf16_t*)(ws + WS_WO), 1024, 1024, (u & 15) * 64, (u >> 4) * 64, 0}; }
    else if (t < 2816) { const int u = t - 1408; j = TrJob{p.w_up, p.norm_ffn_g, (bf16_t*)(ws + WS_WUP), FF2, 1024, (u & 15) * 64, (u >> 4) * 64, 2}; }
    else { const int u = t - 2816; j = TrJob{p.w_down, nullptr, (bf16_t*)(ws + WS_WD), 1024, FF, (u % 44) * 64, (u / 44) * 64, 0}; }
    return j;
}
__device__ __forceinline__ void tr_load(const TrJob& j, float (&v)[8]) {
    const int tid = threadIdx.x, nl = tid & 63, kl = tid >> 6; const int np = j.n0 + nl; const int sc = j.mode == 1 ? colmap_in(np) : (j.mode == 2 ? colmap_up(np) : np);
#pragma unroll
    for (int i = 0; i < 8; ++i) { const int k = j.k0 + kl + 8 * i; v[i] = j.src[(size_t)k * j.Nsrc + sc]; }
    if (j.scale) {
#pragma unroll
        for (int i = 0; i < 8; ++i) v[i] *= j.scale[j.k0 + kl + 8 * i]; }
}
__device__ __forceinline__ void tr_put(LAS float* tile, const float (&v)[8]) { const int tid = threadIdx.x, nl = tid & 63, kl = tid >> 6;
#pragma unroll
    for (int i = 0; i < 8; ++i) tile[nl * 65 + kl + 8 * i] = v[i]; }
__device__ __forceinline__ void tr_store(const LAS float* tile, const TrJob& j) { const int tid = threadIdx.x, nl = tid >> 3, kl = (tid & 7) * 8; const LAS float* tp = tile + nl * 65 + kl; u32x4 w;
    w.x = cvt_pk_bf16(tp[0], tp[1]); w.y = cvt_pk_bf16(tp[2], tp[3]); w.z = cvt_pk_bf16(tp[4], tp[5]); w.w = cvt_pk_bf16(tp[6], tp[7]);
    *(u32x4*)(j.dst + (size_t)(j.n0 + nl) * j.ldd + j.k0 + kl) = w; }

__device__ __forceinline__ void sincos_d(double x, double& s, double& c) {
    const double x2 = x * x; double ts = x, tc = 1.0; s = x; c = 1.0;
#pragma unroll 1
    for (int i = 1; i <= 14; ++i) { tc *= -x2 / (double)((2 * i - 1) * (2 * i)); ts *= -x2 / (double)((2 * i) * (2 * i + 1)); c += tc; s += ts; }
}

__device__ void p0_prep(const Params& p, LAS unsigned char* lds) {
    const int tid = threadIdx.x, G = gridDim.x, bid = blockIdx.x, wave = tid >> 6, lane = tid & 63;
    unsigned char* ws = p.ws;
    { bf16_t* xb = (bf16_t*)(ws + WS_B);
      const int rstep = G * 32; int row0 = (bid * 8 + wave) * 4;
      f32x4 vn[4][4];
      if (row0 < T) {
#pragma unroll
          for (int rr = 0; rr < 4; ++rr) { const f32x4* xr = (const f32x4*)(p.x + (size_t)(row0 + rr) * 1024);
#pragma unroll
              for (int i = 0; i < 4; ++i) vn[rr][i] = __builtin_nontemporal_load(xr + lane + 64 * i); } }
      for (; row0 < T; row0 += rstep) {
          f32x4 v[4][4]; float ss[4];
#pragma unroll
          for (int rr = 0; rr < 4; ++rr)
#pragma unroll
              for (int i = 0; i < 4; ++i) v[rr][i] = vn[rr][i];
          if (row0 + rstep < T) {
#pragma unroll
              for (int rr = 0; rr < 4; ++rr) { const f32x4* xr = (const f32x4*)(p.x + (size_t)(row0 + rstep + rr) * 1024);
#pragma unroll
                  for (int i = 0; i < 4; ++i) vn[rr][i] = __builtin_nontemporal_load(xr + lane + 64 * i); } }
#pragma unroll
          for (int rr = 0; rr < 4; ++rr) { float a = 0.f;
#pragma unroll
              for (int i = 0; i < 4; ++i) a += (v[rr][i][0] * v[rr][i][0] + v[rr][i][1] * v[rr][i][1]) + (v[rr][i][2] * v[rr][i][2] + v[rr][i][3] * v[rr][i][3]);
              ss[rr] = a; }
#pragma unroll
          for (int o = 32; o >= 1; o >>= 1) {
#pragma unroll
              for (int rr = 0; rr < 4; ++rr) ss[rr] += __shfl_xor(ss[rr], o); }
#pragma unroll
          for (int rr = 0; rr < 4; ++rr) { const float rs = rsqrtf(ss[rr] * (1.0f / 1024.0f) + EPS);
#pragma unroll
              for (int i = 0; i < 4; ++i) { u32x2 w; w.x = cvt_pk_bf16(v[rr][i][0] * rs, v[rr][i][1] * rs); w.y = cvt_pk_bf16(v[rr][i][2] * rs, v[rr][i][3] * rs); *(u32x2*)(xb + (size_t)(row0 + rr) * 1024 + (lane + 64 * i) * 4) = w; } }
      } }
    { LAS float* tile0 = (LAS float*)lds;
      for (int t = bid; t < 3520; t += 4 * G) {
          TrJob j[4]; float v[4][8]; bool on[4];
#pragma unroll
          for (int q = 0; q < 4; ++q) { on[q] = (t + q * G) < 3520; j[q] = tr_decode(p, on[q] ? t + q * G : t); tr_load(j[q], v[q]); }
          __syncthreads();
#pragma unroll
          for (int q = 0; q < 4; ++q) tr_put(tile0 + q * (64 * 65), v[q]);
          __syncthreads();
#pragma unroll
          for (int q = 0; q < 4; ++q) if (on[q]) tr_store(tile0 + q * (64 * 65), j[q]);
      }
      __syncthreads();
      bf16_t* W2T = (bf16_t*)(ws + WS_W2);
      { LAS float* wbl = (LAS float*)lds;
        for (int n0 = 4 * bid; n0 < 1024; n0 += 4 * G) {
            *(LAS f32x4*)(wbl + 4 * tid) = *(const f32x4*)(p.w_bp + (size_t)tid * 1024 + n0);
            __syncthreads();
            const int kk = tid, g = kk >> 7; const f32x4* wp = (const f32x4*)(p.w_pool + (size_t)kk * 128); const f32x4* sc = (const f32x4*)(p.pool_scale + g * 128);
            f32x4 acc4 = {0.f, 0.f, 0.f, 0.f};
#pragma unroll 8
            for (int d4 = 0; d4 < 32; ++d4) { const f32x4 w = wp[d4] * sc[d4];
#pragma unroll
                for (int e = 0; e < 4; ++e) acc4 += w[e] * *(const LAS f32x4*)(wbl + 4 * (g * 128 + 4 * d4 + e)); }
#pragma unroll
            for (int e = 0; e < 4; ++e) W2T[(size_t)(n0 + e) * 1024 + 512 + kk] = (bf16_t)(cvt_pk_bf16(acc4[e], 0.f) & 0xffffu);
            __syncthreads();
        } }
      float2* cs = (float2*)(ws + WS_CS);
      for (int idx = bid * 512 + tid; idx < SEQ * 8; idx += G * 512) {
          const int pos = idx >> 3, j = idx & 7;
          const float invf = (j == 0) ? 1.0f : (j == 1) ? 0.1939227432012558f : (j == 2) ? 0.03760603070259094f : (j == 3) ? 0.007292664609849453f : (j == 4) ? 0.0014142135623842478f : (j == 5) ? 0.00027424818836152554f : (j == 6) ? 5.318296098266728e-05f : 1.0313386155758053e-05f;
          const float ang = (float)pos * invf; const double xd = (double)ang; const double kq = rint(xd * 0.15915494309189535); const double r = xd - kq * 6.283185307179586476925;
          double s, c; sincos_d(r, s, c); cs[idx] = make_float2((float)c, (float)s);
      }
    }
}

constexpr int AT_MASK = 0, AT_LIST = 1024, AT_CNT = 9472, AT_TASK = 9600, AT_CTL = 10112, AT_LP = 10240, AT_OP = 14336, AT_OPS = 520;
#define MFMA32(a, b, c) __builtin_amdgcn_mfma_f32_32x32x16_bf16((a), (b), (c), 0, 0, 0)

struct Top3 { float v1, v2, v3; int i1, i2, i3; };
__device__ __forceinline__ void top3_ins(Top3& t, float s, int j) {
    const bool b1 = (s > t.v1) || (s == t.v1 && j < t.i1), b2 = (s > t.v2) || (s == t.v2 && j < t.i2), b3 = (s > t.v3) || (s == t.v3 && j < t.i3);
    if (b1) { t.v3 = t.v2; t.i3 = t.i2; t.v2 = t.v1; t.i2 = t.i1; t.v1 = s; t.i1 = j; }
    else if (b2) { t.v3 = t.v2; t.i3 = t.i2; t.v2 = s; t.i2 = j; }
    else if (b3) { t.v3 = s; t.i3 = j; }
}

template <int FL> __device__ __forceinline__ void attn_item(const Params& p, LAS unsigned char* lds, int bh, int i, bf16_t* apbase) {
    const int tid = threadIdx.x, wave = __builtin_amdgcn_readfirstlane(tid >> 6), lane = tid & 63;
    unsigned char* ws = p.ws;
    LAS unsigned char* OP = lds + AT_OP; LAS float* Lpart = (LAS float*)(lds + AT_LP);
    LAS unsigned* MASK = (LAS unsigned*)(lds + AT_MASK); LAS unsigned char* LIST = (LAS unsigned char*)(lds + AT_LIST); LAS int* CNT = (LAS int*)(lds + AT_CNT);
    LAS unsigned short* TASK = (LAS unsigned short*)(lds + AT_TASK); LAS int* CTL = (LAS int*)(lds + AT_CTL);
    const int b = bh >> 3, h = bh & 7;
    const bf16_t* qb = (const bf16_t*)(ws + WS_Q) + ((size_t)bh * SEQ + (size_t)i * 256) * 64;
    const bf16_t* kb = (const bf16_t*)(ws + WS_K) + (size_t)bh * SEQ * 64;
    const bf16_t* vb = (const bf16_t*)(ws + WS_VT) + (size_t)bh * 32 * 64 * 256;
    const float* kmp = (const float*)(ws + WS_KMP);
    const int r = lane & 31, hh = lane >> 5;
    __syncthreads();
    if (i > 0) {
        f32x16 st;
#pragma unroll
        for (int e = 0; e < 16; ++e) st[e] = 0.f;
        const float* kp = kmp + ((size_t)(((b * 32 + r) * 8 + h) * 2)) * 64 + 8 * hh;
        f32x4 ka[4][4]; bf16x8 qr[4];
#pragma unroll
        for (int s = 0; s < 4; ++s) { qr[s] = *(const bf16x8*)(qb + (size_t)(32 * wave + r) * 64 + 16 * s + 8 * hh);
            if (r < i) { ka[s][0] = *(const f32x4*)(kp + 16 * s); ka[s][1] = *(const f32x4*)(kp + 64 + 16 * s); ka[s][2] = *(const f32x4*)(kp + 16 * s + 4); ka[s][3] = *(const f32x4*)(kp + 64 + 16 * s + 4); }
            else { ka[s][0] = ka[s][1] = ka[s][2] = ka[s][3] = (f32x4){0.f, 0.f, 0.f, 0.f}; } }
#pragma unroll
        for (int s = 0; s < 4; ++s) {
            const f32x4 a0 = (ka[s][0] + ka[s][1]) * (1.0f / 256.0f), a1 = (ka[s][2] + ka[s][3]) * (1.0f / 256.0f);
            u32x4 hi; hi.x = cvt_pk_bf16(a0[0], a0[1]); hi.y = cvt_pk_bf16(a0[2], a0[3]); hi.z = cvt_pk_bf16(a1[0], a1[1]); hi.w = cvt_pk_bf16(a1[2], a1[3]);
            u32x4 lo; lo.x = cvt_pk_bf16(a0[0] - bflo(hi.x), a0[1] - bfhi(hi.x)); lo.y = cvt_pk_bf16(a0[2] - bflo(hi.y), a0[3] - bfhi(hi.y));
            lo.z = cvt_pk_bf16(a1[0] - bflo(hi.z), a1[1] - bfhi(hi.z)); lo.w = cvt_pk_bf16(a1[2] - bflo(hi.w), a1[3] - bfhi(hi.w));
            st = MFMA32(__builtin_bit_cast(bf16x8, hi), qr[s], st); st = MFMA32(__builtin_bit_cast(bf16x8, lo), qr[s], st);
        }
        Top3 t; t.v1 = t.v2 = t.v3 = -INFINITY; t.i1 = t.i2 = t.i3 = 64;
#pragma unroll
        for (int e = 0; e < 16; ++e) { const int j = (e & 3) + 8 * (e >> 2) + 4 * hh; if (j < i) top3_ins(t, st[e], j); }
        const float pv1 = __shfl_xor(t.v1, 32), pv2 = __shfl_xor(t.v2, 32), pv3 = __shfl_xor(t.v3, 32); const int pi1 = __shfl_xor(t.i1, 32), pi2 = __shfl_xor(t.i2, 32), pi3 = __shfl_xor(t.i3, 32);
        if (pi1 < 64) top3_ins(t, pv1, pi1); if (pi2 < 64) top3_ins(t, pv2, pi2); if (pi3 < 64) top3_ins(t, pv3, pi3);
        unsigned mk = 0u; if (t.i1 < 64) mk |= 1u << t.i1; if (t.i2 < 64) mk |= 1u << t.i2; if (t.i3 < 64) mk |= 1u << t.i3;
        if (hh == 0) MASK[32 * wave + r] = mk;
    }
    __syncthreads();
    for (int j = wave; j < i; j += 8) {
        int base = 0;
        for (int c = 0; c < 4; ++c) { const int ql = 64 * c + lane; const bool bit = (MASK[ql] >> j) & 1u; const unsigned long long bal = __ballot(bit);
            const int pre = __popcll(bal & ((1ull << lane) - 1ull)); if (bit) LIST[j * 256 + base + pre] = (unsigned char)ql; base += __popcll(bal); }
        if (lane == 0) CNT[j] = base;
    }
    __syncthreads();
    if (wave == 0) {
        const int nq = (lane < i) ? ((CNT[lane] + 31) >> 5) : 0; int inc = nq;
#pragma unroll
        for (int o = 1; o < 64; o <<= 1) { const int v = __shfl_up(inc, o); if (lane >= o) inc += v; }
        const int st0 = inc - nq, tot = __shfl(inc, 63);
        for (int t = 0; t < nq; ++t) TASK[st0 + t] = (unsigned short)((lane << 8) | t);
        if (lane < 8) TASK[tot + lane] = (unsigned short)((32 << 8) | (7 - lane));
        if (lane == 63) { CTL[0] = 8 + tot; CTL[1] = 0; }
    }
    __syncthreads();
    const int ntask = (FL & 1) ? 0 : CTL[0];
    for (;;) {
        int t = 0; if (lane == 0) t = __hip_atomic_fetch_add(&CTL[1], 1, __ATOMIC_RELAXED, __HIP_MEMORY_SCOPE_WORKGROUP);
        t = __builtin_amdgcn_readfirstlane(t);
        if (t >= ntask) break;
        const int tk = TASK[t], jb = tk >> 8, tile = tk & 255; const bool own = jb == 32; const int j = own ? i : jb;
        const int slot = 32 * tile + r; const int nj = own ? 256 : CNT[j]; const bool valid = slot < nj;
        const int ql = own ? slot : (valid ? (int)LIST[j * 256 + slot] : 0);
        const bf16_t* kj = kb + (size_t)j * 16384 + lane * 8;
        const bf16_t* vj = vb + (size_t)j * 16384 + lane * 8;
        const int nkt = own ? tile + 1 : 8;
        bf16x8 qf[4];
#pragma unroll
        for (int s = 0; s < 4; ++s) qf[s] = *(const bf16x8*)(qb + (size_t)ql * 64 + 16 * s + 8 * hh);
        f32x16 o0, o1; float lsum = 0.f;
#pragma unroll
        for (int e = 0; e < 16; ++e) { o0[e] = 0.f; o1[e] = 0.f; }
#define AT_LOAD(K_, V_, kt_) do { const int c_ = ((kt_) < nkt) ? (kt_) : nkt - 1; \
        _Pragma("unroll") for (int s = 0; s < 4; ++s) K_[s] = *(const bf16x8*)(kj + c_ * 2048 + 512 * s); \
        _Pragma("unroll") for (int dh = 0; dh < 2; ++dh) _Pragma("unroll") for (int s2 = 0; s2 < 2; ++s2) V_[dh][s2] = *(const bf16x8*)(vj + c_ * 2048 + dh * 1024 + 512 * s2); } while (0)
#define AT_COMPUTE(K_, V_, kt_) do { f32x16 st; \
        _Pragma("unroll") for (int e = 0; e < 16; ++e) st[e] = 0.f; \
        _Pragma("unroll") for (int s = 0; s < 4; ++s) st = MFMA32(K_[s], qf[s], st); \
        const bool diag = own && ((kt_) == tile); float pe[16]; \
        _Pragma("unroll") for (int e = 0; e < 16; ++e) { float pv = __builtin_amdgcn_exp2f(st[e]); const int krow = (e & 3) + 8 * (e >> 2) + 4 * hh; if (diag && krow > r) pv = 0.f; pe[e] = pv; lsum += pv; } \
        bf16x8 pb[2]; \
        _Pragma("unroll") for (int s2 = 0; s2 < 2; ++s2) { u32x4 w; w.x = cvt_pk_bf16(pe[8 * s2], pe[8 * s2 + 1]); w.y = cvt_pk_bf16(pe[8 * s2 + 2], pe[8 * s2 + 3]); w.z = cvt_pk_bf16(pe[8 * s2 + 4], pe[8 * s2 + 5]); w.w = cvt_pk_bf16(pe[8 * s2 + 6], pe[8 * s2 + 7]); pb[s2] = __builtin_bit_cast(bf16x8, w); } \
        _Pragma("unroll") for (int s2 = 0; s2 < 2; ++s2) { o0 = MFMA32(V_[0][s2], pb[s2], o0); o1 = MFMA32(V_[1][s2], pb[s2], o1); } } while (0)
        bf16x8 kA[4], vA[2][2], kB[4], vB[2][2], kC[4], vC[2][2];
        AT_LOAD(kA, vA, 0); AT_LOAD(kB, vB, 1);
        for (int kt = 0; kt < nkt; kt += 3) {
            AT_LOAD(kC, vC, kt + 2); AT_COMPUTE(kA, vA, kt);
            if (kt + 1 < nkt) { AT_LOAD(kA, vA, kt + 3); AT_COMPUTE(kB, vB, kt + 1); }
            if (kt + 2 < nkt) { AT_LOAD(kB, vB, kt + 4); AT_COMPUTE(kC, vC, kt + 2); }
        }
#undef AT_LOAD
#undef AT_COMPUTE
        lsum += __shfl_xor(lsum, 32);
        if (valid && !(FL & 2)) {
            const int pr = own ? 3 : __popc(MASK[ql] & ((1u << j) - 1u));
            LAS unsigned char* op = OP + ql * AT_OPS + pr * 128 + 8 * hh;
#pragma unroll
            for (int g4 = 0; g4 < 4; ++g4) { u32x2 w0, w1; w0.x = cvt_pk_bf16(o0[4 * g4], o0[4 * g4 + 1]); w0.y = cvt_pk_bf16(o0[4 * g4 + 2], o0[4 * g4 + 3]); w1.x = cvt_pk_bf16(o1[4 * g4], o1[4 * g4 + 1]); w1.y = cvt_pk_bf16(o1[4 * g4 + 2], o1[4 * g4 + 3]);
                *(LAS u32x2*)(op + 16 * g4) = w0; *(LAS u32x2*)(op + 64 + 16 * g4) = w1; }
            if (hh == 0) Lpart[ql * 4 + pr] = lsum;
        }
    }
    __syncthreads();
    { const int ql = tid >> 1, half = tid & 1; const int np = (i > 0) ? __popc(MASK[ql]) : 0;
      const LAS unsigned char* op = OP + ql * AT_OPS + 64 * half; const LAS float* lp = Lpart + ql * 4;
      float a[32]; float l = 0.f;
#pragma unroll
      for (int c = 0; c < 32; ++c) a[c] = 0.f;
#pragma unroll
      for (int pr = 0; pr < 4; ++pr) { const bool on = (pr == 3) || (pr < np);
          const float lv = lp[pr]; l += on ? lv : 0.f;
#pragma unroll
          for (int c = 0; c < 8; ++c) { const u32x2 w = *(const LAS u32x2*)(op + pr * 128 + 8 * c);
              a[4 * c] += on ? bflo(w.x) : 0.f; a[4 * c + 1] += on ? bfhi(w.x) : 0.f; a[4 * c + 2] += on ? bflo(w.y) : 0.f; a[4 * c + 3] += on ? bfhi(w.y) : 0.f; } }
      const float inv = 1.0f / l;
      bf16_t* dst = apbase + ((size_t)b * SEQ + (size_t)i * 256 + ql) * 1024 + h * 64 + 32 * half;
#pragma unroll
      for (int c = 0; c < 4; ++c) { u32x4 w; w.x = cvt_pk_bf16(a[8 * c] * inv, a[8 * c + 1] * inv); w.y = cvt_pk_bf16(a[8 * c + 2] * inv, a[8 * c + 3] * inv);
          w.z = cvt_pk_bf16(a[8 * c + 4] * inv, a[8 * c + 5] * inv); w.w = cvt_pk_bf16(a[8 * c + 6] * inv, a[8 * c + 7] * inv); *(u32x4*)(dst + 8 * c) = w; } }
}

__device__ __forceinline__ void acc8(float (&sum)[8], const u32x4& x, float sg) {
    sum[0] += sg * bflo(x.x); sum[1] += sg * bfhi(x.x); sum[2] += sg * bflo(x.y); sum[3] += sg * bfhi(x.y); sum[4] += sg * bflo(x.z); sum[5] += sg * bfhi(x.z); sum[6] += sg * bflo(x.w); sum[7] += sg * bfhi(x.w); }
__device__ __forceinline__ void pool_unit(const Params& p, int unit, bf16_t* ap) {
    const int tid = threadIdx.x, wave = tid >> 6, lane = tid & 63;
    const bf16_t* u = (const bf16_t*)(p.ws + WS_U);
    const int g = lane >> 4, w = 2 << g, t0 = unit * 64 + wave * 8, pos0 = t0 & (SEQ - 1);
    const bf16_t* ub = u + (size_t)t0 * 512 + lane * 8;
    const u32x4 zero = {0u, 0u, 0u, 0u};
    u32x4 xc[8], yr[8];
#pragma unroll
    for (int s = 0; s < 8; ++s) xc[s] = *(const u32x4*)(ub + s * 512);
#pragma unroll
    for (int s = 0; s < 8; ++s) yr[s] = (pos0 + s - w >= 0) ? *(const u32x4*)(ub + (s - w) * 512) : zero;
    float sum[8];
#pragma unroll
    for (int c = 0; c < 8; ++c) sum[c] = 0.f;
#pragma unroll
    for (int hb = 0; hb < 2; ++hb) {
        u32x4 h[8];
#pragma unroll
        for (int k = 0; k < 8; ++k) { const int d = 1 + 8 * hb + k; h[k] = (d < w && pos0 - d >= 0) ? *(const u32x4*)(ub - d * 512) : zero; }
#pragma unroll
        for (int k = 0; k < 8; ++k) acc8(sum, h[k], 1.f);
    }
    { const u32x4 y = yr[0]; acc8(sum, y, 1.f); }
#pragma unroll
    for (int s = 0; s < 8; ++s) {
        acc8(sum, xc[s], 1.f); acc8(sum, yr[s], -1.f);
        const int pos = pos0 + s; const float inv = 1.0f / (float)((pos + 1 < w) ? pos + 1 : w);
        const u32x4 x = xc[s]; const float cur[8] = {bflo(x.x), bfhi(x.x), bflo(x.y), bfhi(x.y), bflo(x.z), bfhi(x.z), bflo(x.w), bfhi(x.w)};
        u32x4 o; o.x = cvt_pk_bf16(sum[0] * inv - cur[0], sum[1] * inv - cur[1]); o.y = cvt_pk_bf16(sum[2] * inv - cur[2], sum[3] * inv - cur[3]);
        o.z = cvt_pk_bf16(sum[4] * inv - cur[4], sum[5] * inv - cur[5]); o.w = cvt_pk_bf16(sum[6] * inv - cur[6], sum[7] * inv - cur[7]);
        *(u32x4*)(ap + (size_t)(t0 + s) * 1024 + 512 + lane * 8) = o;
    }
}

__device__ void fixup_panel(const Params& p, int pm) {
    const float* halo = (const float*)(p.ws + WS_HALO); bf16_t* act = (bf16_t*)(p.ws + WS_ACT);
    const float* cw = p.conv_w; const float* cb = p.conv_b;
    const int g0 = 2 * pm; const bool first = (g0 & 63) == 0;
    const float* hm = halo + (size_t)(g0 - 1) * 4 * FF2; const float* h0 = halo + (size_t)g0 * 4 * FF2; const float* h1 = h0 + 4 * FF2;
#pragma unroll 2
    for (int c = threadIdx.x; c < FF; c += 512) {
        const int npg = 256 * (c >> 7) + (c & 127), npv = npg + 128;
        const float w0g = cw[c], w1g = cw[FF2 + c], w2g = cw[2 * FF2 + c], bg = cb[c], w0v = cw[FF + c], w1v = cw[FF2 + FF + c], w2v = cw[2 * FF2 + FF + c], bv = cb[FF + c];
        const float gm2 = first ? 0.f : hm[2 * FF2 + npg], gm1 = first ? 0.f : hm[3 * FF2 + npg], vm2 = first ? 0.f : hm[2 * FF2 + npv], vm1 = first ? 0.f : hm[3 * FF2 + npv];
        const float ga0 = h0[npg], ga1 = h0[FF2 + npg], ga2 = h0[2 * FF2 + npg], ga3 = h0[3 * FF2 + npg], va0 = h0[npv], va1 = h0[FF2 + npv], va2 = h0[2 * FF2 + npv], va3 = h0[3 * FF2 + npv];
        const float gb0 = h1[npg], gb1 = h1[FF2 + npg], vb0 = h1[npv], vb1 = h1[FF2 + npv];
        float cg[4], cv[4];
        cg[0] = w0g * gm2 + w1g * gm1 + w2g * ga0 + bg; cv[0] = w0v * vm2 + w1v * vm1 + w2v * va0 + bv;
        cg[1] = w0g * gm1 + w1g * ga0 + w2g * ga1 + bg; cv[1] = w0v * vm1 + w1v * va0 + w2v * va1 + bv;
        cg[2] = w0g * ga2 + w1g * ga3 + w2g * gb0 + bg; cv[2] = w0v * va2 + w1v * va3 + w2v * vb0 + bv;
        cg[3] = w0g * ga3 + w1g * gb0 + w2g * gb1 + bg; cv[3] = w0v * va3 + w1v * vb0 + w2v * vb1 + bv;
#pragma unroll
        for (int q = 0; q < 4; ++q) { const float a = cg[q] * __builtin_amdgcn_rcpf(1.f + __expf(-cg[q])) * cv[q];
            act[(size_t)((g0 + (q >> 1)) * 128 + (q & 1)) * FF + c] = (bf16_t)(cvt_pk_bf16(a, 0.f) & 0xffffu); }
    }
}

#define XB_TMO      128
#define XB_XCNT(j)  (256  + 64 * (j))
#define XB_XSUB(j)  (1280 + 64 * (j))
#define XB_XGEN(j)  (2304 + 64 * (j))
#define XB_TOP      3328
#define XB_TOPGEN   3392
#define XCD_BAR_WORDS 3456
#define XB_SPIN_CAP (1u << 18)

__device__ __forceinline__ unsigned xb_ld(unsigned* p)              { return __hip_atomic_load(p, __ATOMIC_RELAXED, __HIP_MEMORY_SCOPE_AGENT); }
__device__ __forceinline__ unsigned xb_add(unsigned* p, unsigned v) { return __hip_atomic_fetch_add(p, v, __ATOMIC_RELAXED, __HIP_MEMORY_SCOPE_AGENT); }
__device__ __forceinline__ unsigned xb_xcc_id() { return (unsigned)__builtin_amdgcn_s_getreg((3 << 11) | 20) & 0xFu; }
#define XB_SPIN(cond, bar) do { unsigned _sp = 0; while (cond) { __builtin_amdgcn_s_sleep(1); \
    if ((++_sp & 255u) == 0u) { if (xb_ld(&(bar)[XB_TMO])) break; if (_sp > XB_SPIN_CAP) { atomicAdd(&(bar)[XB_TMO], 1u); break; } } } } while (0)

struct XcdBarrier {
    unsigned* bar; unsigned x;
    volatile LAS unsigned* st;
};

__device__ __forceinline__ XcdBarrier xcd_barrier_post(unsigned* bar, volatile LAS unsigned* st) {
    XcdBarrier b; b.bar = bar; b.x = xb_xcc_id(); b.st = st;
    if (threadIdx.x == 0) (void)xb_add(&bar[XB_XCNT(b.x)], 1u);
    return b;
}
__device__ __forceinline__ void xcd_barrier_complete(unsigned* bar, unsigned x, unsigned& nloc, unsigned& nx) {
    const unsigned G = gridDim.x * gridDim.y * gridDim.z;
    unsigned sum, cnt, mine, sp = 0u;
    for (;;) {
        sum = 0u; cnt = 0u; mine = 0u;
#pragma unroll
        for (unsigned j = 0; j < 16; ++j) { const unsigned c = xb_ld(&bar[XB_XCNT(j)]); sum += c; cnt += (c > 0u) ? 1u : 0u; mine = (j == x) ? c : mine; }
        if (sum == G) break;
        __builtin_amdgcn_s_sleep(1);
        if ((++sp & 255u) == 0u) { if (xb_ld(&bar[XB_TMO])) break; if (sp > XB_SPIN_CAP) { atomicAdd(&bar[XB_TMO], 1u); break; } }
    }
    nloc = mine > 0u ? mine : 1u; nx = cnt > 0u ? cnt : 1u;
}

__device__ __forceinline__ void xcd_barrier(const XcdBarrier& b) {
    asm volatile("s_waitcnt vmcnt(0)" ::: "memory");
    __syncthreads();
    if (threadIdx.x == 0) {
        unsigned* bar = b.bar;
        __builtin_amdgcn_s_waitcnt(0);
        unsigned nloc = b.st[0], nx = b.st[1];
        if (nloc == 0u) { xcd_barrier_complete(bar, b.x, nloc, nx); b.st[0] = nloc; b.st[1] = nx; }
        const unsigned old = xb_add(&bar[XB_XSUB(b.x)], 1u);
        const unsigned gen = old / nloc;
        if (old + 1u == (gen + 1u) * nloc) {
            __builtin_amdgcn_fence(__ATOMIC_RELEASE, "agent");
            asm volatile("s_waitcnt vmcnt(0)" ::: "memory");
            const unsigned og = xb_add(&bar[XB_TOP], 1u);
            const unsigned tg = og / nx;
            if (og + 1u == (tg + 1u) * nx) xb_add(&bar[XB_TOPGEN], 1u);
            else XB_SPIN(xb_ld(&bar[XB_TOPGEN]) == tg, bar);
            __builtin_amdgcn_fence(__ATOMIC_ACQUIRE, "agent");
            xb_add(&bar[XB_XGEN(b.x)], 1u);
            asm volatile("s_waitcnt vmcnt(0)" ::: "memory");
        } else {
            XB_SPIN(xb_ld(&bar[XB_XGEN(b.x)]) == gen, bar);
            __builtin_amdgcn_fence(__ATOMIC_ACQUIRE, "agent");
            asm volatile("s_waitcnt vmcnt(0)" ::: "memory");
        }
    }
    __syncthreads();
}

__global__ void __launch_bounds__(512, 2) fwd_kernel(Params p) {
    extern __shared__ __attribute__((aligned(16))) unsigned char smem[];
    LAS unsigned char* lds = (LAS unsigned char*)smem;
    cg::grid_group grid = cg::this_grid();
    unsigned char* ws = p.ws;
    const int lo = p.ph_lo, hi = p.ph_hi, G = gridDim.x, bid = blockIdx.x;
#ifndef PHASE_MASK
#define PHASE_MASK 0xFF
#endif
#define IN(k) (((PHASE_MASK >> (k)) & 1) && lo <= (k) && (k) < hi)
    XcdBarrier xbar; xbar.bar = (unsigned*)(ws + WS_BAR); xbar.x = 0; xbar.st = (volatile LAS unsigned*)(lds + 147456);
    const bool multi = (hi - lo) > 1;
    if (multi) { if (threadIdx.x < 2) xbar.st[threadIdx.x] = 0u; __syncthreads(); xbar = xcd_barrier_post((unsigned*)(ws + WS_BAR), (volatile LAS unsigned*)(lds + 147456)); }
#define SEAM(k) do { if (IN(k) && IN((k) + 1)) xcd_barrier(xbar); } while (0)
    if (hi == 1000) grid.sync();
    if (IN(0)) p0_prep(p, lds);
    SEAM(0);
    if (IN(1)) {
        pg8::Gemm g{(const bf16_t*)(ws + WS_B), (const bf16_t*)(ws + WS_WIN), T, INW, DM}; pg8::StaticOrder S; S.init(T, INW, G, bid);
        EpiG1 E{(bf16_t*)(ws + WS_Q), (bf16_t*)(ws + WS_K), (bf16_t*)(ws + WS_VT), (bf16_t*)(ws + WS_U), (bf16_t*)(ws + WS_C), (bf16_t*)(ws + WS_D), (float*)(ws + WS_KMP), p.q_norm_g, p.k_norm_g, p.b_gate, (const float2*)(ws + WS_CS)};
        pg8::gemm_phase<EpiG1>(lds, g, S, E);
    }
    SEAM(1);
    if (IN(2)) {
        for (int it = bid; it < 1024; it += G) { const int xcd = it & 7, rest = it >> 3, s_ = rest & 31, kk = rest >> 5; const int j_ = (s_ + 16 * (kk >> 1)) & 31, i = (kk & 1) ? 31 - j_ : j_;
            attn_item<0>(p, lds, kk * 8 + xcd, i, (bf16_t*)(ws + WS_AP)); }
        for (int un = bid; un < 512; un += G) pool_unit(p, un, (bf16_t*)(ws + WS_AP));
        __syncthreads();
    }
#ifdef PROBE_VARIANTS
#if PROBE_VARIANTS == 12
    if (lo == 12) { pg8::Gemm g{(const bf16_t*)(ws + WS_C), (const bf16_t*)(ws + WS_WUP), T, FF2, DM}; pg8::StaticOrder S; S.init(T, FF2, G, bid); EpiNull<true> E{(float*)(ws + WS_END)}; pg8::gemm_phase<EpiNull<true>>(lds, g, S, E); }
#elif PROBE_VARIANTS == 13
    if (lo == 13) { pg8::Gemm g{(const bf16_t*)(ws + WS_ACT), (const bf16_t*)(ws + WS_WD), T, DM, FF}; pg8::StaticOrder S; S.init(T, DM, G, bid); EpiNull<false> E{(float*)(ws + WS_END)}; pg8::gemm_phase<EpiNull<false>>(lds, g, S, E); }
#elif PROBE_VARIANTS == 14
    if (lo == 14) { pg8::Gemm g{(const bf16_t*)(ws + WS_B), (const bf16_t*)(ws + WS_WIN), T, INW, DM}; pg8::StaticOrder S; S.init(T, INW, G, bid); EpiNull<true> E{(float*)(ws + WS_END)}; pg8::gemm_phase<EpiNull<true>>(lds, g, S, E); }
#elif PROBE_VARIANTS == 8
    if (lo == 8) for (int it = bid; it < 1024; it += G) { const int xcd = it & 7, rest = it >> 3, i = rest & 31, kk = rest >> 5; attn_item<0>(p, lds, kk * 8 + xcd, i, (bf16_t*)(ws + WS_END)); }
#elif PROBE_VARIANTS == 9
    if (lo == 9) for (int un = bid; un < 512; un += G) pool_unit(p, un, (bf16_t*)(ws + WS_END));
#elif PROBE_VARIANTS == 10
    if (lo == 10) for (int it = bid; it < 1024; it += G) { const int xcd = it & 7, rest = it >> 3, i = rest & 31, kk = rest >> 5; attn_item<1>(p, lds, kk * 8 + xcd, i, (bf16_t*)(ws + WS_END)); }
#elif PROBE_VARIANTS == 11
    if (lo == 11) for (int it = bid; it < 1024; it += G) { const int xcd = it & 7, rest = it >> 3, i = rest & 31, kk = rest >> 5; attn_item<2>(p, lds, kk * 8 + xcd, i, (bf16_t*)(ws + WS_END)); }
#endif
#endif
    SEAM(2);
    if (IN(3)) {
        pg8::Gemm g{(const bf16_t*)(ws + WS_AP), (const bf16_t*)(ws + WS_W2), T, DM, DM}; pg8::StaticOrder S; S.init(T, DM, G, bid);
        EpiG2 E{(const bf16_t*)(ws + WS_C), (const bf16_t*)(ws + WS_D), (bf16_t*)(ws + WS_B)};
        pg8::gemm_phase<EpiG2>(lds, g, S, E);
    }
    SEAM(3);
    if (IN(4)) {
        pg8::Gemm g{(const bf16_t*)(ws + WS_B), (const bf16_t*)(ws + WS_WO), T, DM, DM}; pg8::StaticOrder S; S.init(T, DM, G, bid);
        EpiG3 E{p.x, (bf16_t*)(ws + WS_C), (float*)(ws + WS_SSQ)};
        pg8::gemm_phase<EpiG3>(lds, g, S, E);
    }
    SEAM(4);
    if (IN(5)) {
        pg8::Gemm g{(const bf16_t*)(ws + WS_C), (const bf16_t*)(ws + WS_WUP), T, FF2, DM}; pg8::StaticOrder S; S.init(T, FF2, G, bid);
        EpiG4 E{(const float*)(ws + WS_SSQ), p.conv_w, p.conv_b, (bf16_t*)(ws + WS_ACT), (float*)(ws + WS_HALO), (LAS float*)(lds + 131072)};
        if ((threadIdx.x & 63) == 0) ((LAS int*)(lds + 131072))[(threadIdx.x >> 6) * 400 + 384] = -1;
        pg8::gemm_phase<EpiG4>(lds, g, S, E);
    }
    if (IN(5) && IN(7)) xcd_barrier(xbar);
    if (IN(7)) {
        pg8::Gemm g{(const bf16_t*)(ws + WS_ACT), (const bf16_t*)(ws + WS_WD), T, DM, FF}; pg8::StaticOrder S; S.init(T, DM, G, bid);
        { Unit u; int last = -1; for (int ui = 0; S.next(ui, u); ++ui) { if (u.pm != last) fixup_panel(p, u.pm); last = u.pm; } __syncthreads(); }
        EpiG5 E{(const bf16_t*)(ws + WS_C), p.out};
        pg8::gemm_phase<EpiG5>(lds, g, S, E);
    }
#undef IN
#undef SEAM
}

#ifndef N_LAUNCH_MODE
#define N_LAUNCH_MODE 1
#endif

extern "C" void kernel_launch(void* const* d_in, const int* in_sizes, int n_in, void* d_out, int out_size, void* d_ws, size_t ws_size, hipStream_t stream) {
    static int grid = 0;
    if (grid == 0) {
        if (n_in != 16 || out_size != T * DM || ws_size < WS_END + 64 * MiB) { fprintf(stderr, "kernel_launch: unexpected shapes (n_in %d out %d ws %zu need %zu)\n", n_in, out_size, ws_size, (size_t)WS_END); grid = -1; return; }
        int dev = 0, cus = 0, per_cu = 0;
        hipGetDevice(&dev); hipDeviceGetAttribute(&cus, hipDeviceAttributeMultiprocessorCount, dev);
        if (hipFuncSetAttribute((const void*)fwd_kernel, hipFuncAttributeMaxDynamicSharedMemorySize, LDS_BYTES) != hipSuccess) { fprintf(stderr, "kernel_launch: hipFuncSetAttribute failed\n"); grid = -1; return; }
        if (hipOccupancyMaxActiveBlocksPerMultiprocessor(&per_cu, (const void*)fwd_kernel, 512, LDS_BYTES) != hipSuccess || per_cu < 1) { fprintf(stderr, "kernel_launch: occupancy query says %d\n", per_cu); per_cu = 1; }
        (void)hipGetLastError();
        grid = cus < 256 ? cus : 256;
    }
    if (grid < 0) return;
    Params p{};
    p.x = (const float*)d_in[0]; p.norm_mix_g = (const float*)d_in[1]; p.w_in = (const float*)d_in[2]; p.b_gate = (const float*)d_in[3]; p.q_norm_g = (const float*)d_in[4]; p.k_norm_g = (const float*)d_in[5];
    p.w_pool = (const float*)d_in[6]; p.pool_scale = (const float*)d_in[7]; p.w_ba = (const float*)d_in[8]; p.w_bp = (const float*)d_in[9]; p.w_out = (const float*)d_in[10]; p.norm_ffn_g = (const float*)d_in[11];
    p.w_up = (const float*)d_in[12]; p.conv_w = (const float*)d_in[13]; p.conv_b = (const float*)d_in[14]; p.w_down = (const float*)d_in[15];
    p.out = (float*)d_out; p.ws = (unsigned char*)d_ws;
#if N_LAUNCH_MODE == 1
    p.ph_lo = 0; p.ph_hi = 8;
    if (hipMemsetAsync((unsigned char*)d_ws + WS_BAR, 0, 16384, stream) != hipSuccess) { fprintf(stderr, "kernel_launch: memset of the barrier words failed\n"); return; }
    void* args[] = {&p};
    hipError_t e = hipLaunchCooperativeKernel((const void*)fwd_kernel, dim3(grid), dim3(512), args, LDS_BYTES, stream);
    if (e != hipSuccess) fprintf(stderr, "cooperative launch failed: %s (grid %d)\n", hipGetErrorString(e), grid);
#else
    for (int k = 0; k < 8; ++k) { p.ph_lo = k; p.ph_hi = k + 1; hipLaunchKernelGGL(fwd_kernel, dim3(grid), dim3(512), LDS_BYTES, stream, p);
#ifdef PROBE_G5_EARLY
        if (k == 3) { Params pv = p; pv.ph_lo = 7; pv.ph_hi = 8; hipLaunchKernelGGL(fwd_kernel, dim3(grid), dim3(512), LDS_BYTES, stream, pv); }
#endif
#ifdef PROBE_PHASE
        if (k == PROBE_PHASE) hipLaunchKernelGGL(fwd_kernel, dim3(grid), dim3(512), LDS_BYTES, stream, p);
#endif
#ifdef PROBE_VARIANTS
        if (k == (PROBE_VARIANTS == 12 ? 5 : PROBE_VARIANTS == 13 ? 6 : PROBE_VARIANTS == 14 ? 1 : 2)) { Params pv = p; pv.ph_lo = PROBE_VARIANTS; pv.ph_hi = PROBE_VARIANTS + 1; hipLaunchKernelGGL(fwd_kernel, dim3(grid), dim3(512), LDS_BYTES, stream, pv); }
#endif
    }
#endif
}
```

```cpp
#include <hip/hip_runtime.h>
#include <hip/hip_cooperative_groups.h>
#include <cstdio>
namespace cg = cooperative_groups;

#define LAS __attribute__((address_space(3)))
typedef unsigned short bf16_t;
typedef short bf16x8 __attribute__((ext_vector_type(8)));
typedef short s16x4 __attribute__((ext_vector_type(4)));
typedef float f32x4 __attribute__((ext_vector_type(4)));
typedef float f32x16 __attribute__((ext_vector_type(16)));
typedef unsigned u32x4 __attribute__((ext_vector_type(4)));
typedef unsigned u32x2 __attribute__((ext_vector_type(2)));

constexpr int T = 32768, DM = 1024, SEQ = 8192, NH = 8, DH = 64, NBLK = 32, FF = 2816, FF2 = 5632, INW = 4096;
constexpr float EPS = 1e-6f;
constexpr size_t MiB = 1024 * 1024;
constexpr size_t WS_WIN = 0;
constexpr size_t WS_W2 = 8 * MiB;
constexpr size_t WS_WO = 10 * MiB;
constexpr size_t WS_WUP = 12 * MiB;
constexpr size_t WS_WD = 23 * MiB;
constexpr size_t WS_CS = 29 * MiB;
constexpr size_t WS_KMP = 29 * MiB + 512 * 1024;
constexpr size_t WS_RINV = 30 * MiB;
constexpr size_t WS_BAR = 31 * MiB;
constexpr size_t WS_A = 32 * MiB;
constexpr size_t WS_Q = WS_A, WS_K = WS_A + 32 * MiB, WS_VT = WS_A + 64 * MiB, WS_U = WS_A + 96 * MiB, WS_AP = WS_A + 128 * MiB;
constexpr size_t WS_ACT = WS_A;
constexpr size_t WS_B = WS_A + 192 * MiB;
constexpr size_t WS_C = WS_B + 64 * MiB;
constexpr size_t WS_D = WS_C + 64 * MiB;
constexpr size_t WS_HALO = WS_D, WS_SSQ = WS_D + 24 * MiB;
constexpr size_t WS_END = WS_D + 64 * MiB;
constexpr int LDS_BYTES = 147456 + 64;

struct Params {
    const float *x, *norm_mix_g, *w_in, *b_gate, *q_norm_g, *k_norm_g, *w_pool, *pool_scale, *w_ba, *w_bp, *w_out, *norm_ffn_g, *w_up, *conv_w, *conv_b, *w_down;
    float* out; unsigned char* ws; int ph_lo, ph_hi;
};

__device__ __forceinline__ unsigned cvt_pk_bf16(float lo, float hi) { unsigned r; asm volatile("v_cvt_pk_bf16_f32 %0, %1, %2" : "=v"(r) : "v"(lo), "v"(hi)); return r; }
__device__ __forceinline__ float bf2f(unsigned short b) { return __uint_as_float(((unsigned)b) << 16); }
__device__ __forceinline__ float bflo(unsigned w) { return __uint_as_float(w << 16); }
__device__ __forceinline__ float bfhi(unsigned w) { return __uint_as_float(w & 0xffff0000u); }

namespace pg8 {
constexpr int BM = 256, BK = 64, HALF = 128, HTB = HALF * BK * 2, STAGE_BYTES = 8 * HTB, NXCD = 8, WGM = 8;
__host__ __device__ __forceinline__ int lds_byte(int r, int c) { const int st = (r >> 4) * 2 + (c >> 5), rr = r & 15, cc = c & 31, ob = rr * 64 + cc * 2; return st * 1024 + (ob ^ (((ob >> 9) & 1) << 5)); }
__host__ __device__ __forceinline__ void stage_rc(int b, int& R, int& C) { const int st = b / 1024, sb = b % 1024, swz = sb ^ (((sb >> 9) & 1) << 5); R = (st >> 1) * 16 + swz / 64; C = (st & 1) * 32 + (swz % 64) / 2; }
__host__ __device__ __forceinline__ int perm32(int rho) { const int n = rho >> 4, i = rho & 15; return 8 * (i >> 2) + 4 * n + (i & 3); }
struct Unit { int pm, pn; };
struct Gemm { const bf16_t* A; const bf16_t* Bt; int M, N, K; };
struct StaticOrder {
    int nM, nN, nwg, G, c;
    __host__ __device__ void init(int M, int N, int G_, int c_) { nM = M / BM; nN = N / BM; nwg = nM * nN; G = G_; c = c_; }
    __host__ __device__ bool next(int i, Unit& u) const {
        const long L = (long)i * G + c; if (L >= nwg) return false;
        int wgid = (int)L; { const int q = nwg / NXCD, r = nwg % NXCD, xcd = wgid % NXCD, off = wgid / NXCD; wgid = (xcd < r ? xcd * (q + 1) : r * (q + 1) + (xcd - r) * q) + off; }
        const int nig = WGM * nN, gid = wgid / nig, fm = gid * WGM, gsz = (nM - fm) < WGM ? (nM - fm) : WGM;
        u.pm = fm + ((wgid % nig) % gsz); u.pn = (wgid % nig) / gsz; return true;
    }
};

template <class Epi>
__device__ __forceinline__ void gemm_phase(LAS unsigned char* lds, const Gemm g, const StaticOrder& S, const Epi& E) {
    const int tid = threadIdx.x, wid = __builtin_amdgcn_readfirstlane(tid >> 6), lane = tid & 63, wr = wid >> 2, wc = wid & 3, fr = lane & 15, fq = lane >> 4;
    const int K = g.K, nt = K / BK;
    unsigned voffA[2], voffB[2];
#pragma unroll
    for (int i = 0; i < 2; ++i) { int R, C; stage_rc(tid * 16 + i * 8192, R, C); const int Rb = Epi::PERM ? ((R & ~31) + perm32(R & 31)) : R;
        const int Ra = Epi::APERM ? (8 * (16 * (R >> 6) + (R & 15)) + ((R >> 4) & 3)) : R;
        voffA[i] = (unsigned)(Ra * K + C) * 2u; voffB[i] = (unsigned)(Rb * K + C) * 2u; }
    const size_t kstep = (size_t)(BK * 2);
    const size_t hstep = (size_t)HALF * K * 2;
    const size_t hstepA = Epi::APERM ? (size_t)4 * K * 2 : hstep;
    const size_t tstep = 2 * hstep;
    const unsigned ldsw = (unsigned)wid * 1024u;
    const int aoff = lds_byte(wr * 64 + fr, fq * 8), boff = lds_byte(wc * 32 + fr, fq * 8);
#define PG8_SA(b, h) (((b) * 2 + (h)) * HTB)
#define PG8_SB(b, h) ((4 + (b) * 2 + (h)) * HTB)
#define PG8_STAGE(bufoff, gbase, voff) do { _Pragma("unroll") for (int _i = 0; _i < 2; ++_i) \
        __builtin_amdgcn_global_load_lds((const unsigned*)((const char*)(gbase) + (voff)[_i]), (LAS unsigned*)(lds + (bufoff) + ldsw + _i * 8192), 16, 0, 0); } while (0)
#define PG8_LDA(dst, b, h) do { _Pragma("unroll") for (int m = 0; m < 4; ++m) _Pragma("unroll") for (int k = 0; k < 2; ++k) dst[m][k] = *(const LAS bf16x8*)(lds + PG8_SA(b, h) + aoff + m * 2048 + k * 1024); } while (0)
#define PG8_LDB(dst, b, h) do { _Pragma("unroll") for (int n = 0; n < 2; ++n) _Pragma("unroll") for (int k = 0; k < 2; ++k) dst[n][k] = *(const LAS bf16x8*)(lds + PG8_SB(b, h) + boff + n * 2048 + k * 1024); } while (0)
#define PG8_MMA(ai, bj, At, Bt) do { __builtin_amdgcn_s_setprio(1); _Pragma("unroll") for (int m = 0; m < 4; ++m) _Pragma("unroll") for (int n = 0; n < 2; ++n) _Pragma("unroll") for (int k = 0; k < 2; ++k) \
        acc[ai][bj][m][n] = __builtin_amdgcn_mfma_f32_16x16x32_bf16(Bt[n][k], At[m][k], acc[ai][bj][m][n], 0, 0, 0); __builtin_amdgcn_s_setprio(0); } while (0)
#define PG8_WAIT_V(n) asm volatile("s_waitcnt vmcnt(" #n ")" ::: "memory")
#define PG8_WAIT_L(n) asm volatile("s_waitcnt lgkmcnt(" #n ")" ::: "memory")
#define PG8_BAR __builtin_amdgcn_s_barrier()
#define PG8_SCHED __builtin_amdgcn_sched_barrier(0)
    Unit cur, nxt; int ui = 0;
    if (!S.next(0, cur)) return;
    f32x4 acc[2][2][4][2];
#pragma unroll
    for (int a = 0; a < 2; ++a)
#pragma unroll
        for (int b = 0; b < 2; ++b)
#pragma unroll
            for (int m = 0; m < 4; ++m)
#pragma unroll
                for (int n = 0; n < 2; ++n) acc[a][b][m][n] = (f32x4){0.f, 0.f, 0.f, 0.f};
    bf16x8 At[4][2], B0[2][2], B1[2][2];
    const char* cA = (const char*)g.A + (size_t)cur.pm * tstep; const char* cB = (const char*)g.Bt + (size_t)cur.pn * tstep;
    PG8_STAGE(PG8_SB(0, 0), cB, voffB); PG8_STAGE(PG8_SB(0, 1), cB + hstep, voffB); PG8_STAGE(PG8_SA(0, 0), cA, voffA); PG8_STAGE(PG8_SA(0, 1), cA + hstepA, voffA);
    if (wr == 1) PG8_BAR;
    PG8_WAIT_V(2); PG8_BAR;
    PG8_STAGE(PG8_SB(1, 0), cB + kstep, voffB); PG8_STAGE(PG8_SA(1, 0), cA + kstep, voffA); PG8_STAGE(PG8_SB(1, 1), cB + hstep + kstep, voffB);
    PG8_WAIT_V(6); PG8_BAR;
    for (;;) {
        const bool has_next = S.next(ui + 1, nxt);
        const char* nA = has_next ? (const char*)g.A + (size_t)nxt.pm * tstep : cA; const char* nB = has_next ? (const char*)g.Bt + (size_t)nxt.pn * tstep : cB;
        for (int t = 0; t < nt; t += 2) {
            const bool last = (t == nt - 2);
            const char* a1 = cA + (size_t)(t + 1) * kstep;
            const char* a2 = last ? nA : cA + (size_t)(t + 2) * kstep; const char* b2 = last ? nB : cB + (size_t)(t + 2) * kstep;
            const char* a3 = a2 + kstep; const char* b3 = b2 + kstep;
            if constexpr (Epi::MID) { if (t == Epi::MID_T) E.mid(acc, cur, wr, wc, fr, fq); }
            if constexpr (Epi::PRE) { if (last) E.pre(cur, wr, wc, lane); }
            PG8_LDB(B0, 0, 0); PG8_LDB(B1, 0, 1); PG8_SCHED; PG8_LDA(At, 0, 0); PG8_STAGE(PG8_SA(1, 1), a1 + hstepA, voffA);
            PG8_WAIT_V(8); PG8_WAIT_L(0); PG8_BAR; PG8_MMA(0, 0, At, B0); PG8_MMA(0, 1, At, B1); PG8_BAR; PG8_SCHED;
            PG8_LDA(At, 0, 1); PG8_STAGE(PG8_SB(0, 0), b2, voffB); PG8_STAGE(PG8_SB(0, 1), b2 + hstep, voffB); PG8_STAGE(PG8_SA(0, 0), a2, voffA);
            PG8_WAIT_V(8); PG8_WAIT_L(0); PG8_BAR; PG8_MMA(1, 0, At, B0); PG8_MMA(1, 1, At, B1); PG8_BAR; PG8_SCHED;
            PG8_LDB(B0, 1, 0); PG8_LDB(B1, 1, 1); PG8_SCHED; PG8_LDA(At, 1, 0); PG8_STAGE(PG8_SA(0, 1), a2 + hstepA, voffA);
            PG8_WAIT_V(8); PG8_WAIT_L(0); PG8_BAR; PG8_MMA(0, 0, At, B0); PG8_MMA(0, 1, At, B1); PG8_BAR; PG8_SCHED;
            PG8_LDA(At, 1, 1); PG8_STAGE(PG8_SB(1, 0), b3, voffB); PG8_STAGE(PG8_SB(1, 1), b3 + hstep, voffB); PG8_STAGE(PG8_SA(1, 0), a3, voffA);
            PG8_WAIT_V(8); PG8_WAIT_L(0); PG8_BAR; PG8_MMA(1, 0, At, B0); PG8_MMA(1, 1, At, B1); PG8_BAR; PG8_SCHED;
        }
        if (wr == 0) PG8_BAR;
        E(acc, cur, wr, wc, fr, fq);
        if (!has_next) break;
#pragma unroll
        for (int a = 0; a < 2; ++a)
#pragma unroll
            for (int b = 0; b < 2; ++b)
#pragma unroll
                for (int m = 0; m < 4; ++m)
#pragma unroll
                    for (int n = 0; n < 2; ++n) acc[a][b][m][n] = (f32x4){0.f, 0.f, 0.f, 0.f};
        cur = nxt; cA = nA; cB = nB; ++ui;
        if (wr == 1) PG8_BAR;
    }
    PG8_WAIT_V(0);
    PG8_BAR;
#undef PG8_SA
#undef PG8_SB
#undef PG8_STAGE
#undef PG8_LDA
#undef PG8_LDB
#undef PG8_MMA
#undef PG8_WAIT_V
#undef PG8_WAIT_L
#undef PG8_BAR
#undef PG8_SCHED
}
}
using pg8::Unit;

struct EpiG1 {
    static constexpr bool PERM = true, APERM = true, MID = false, PRE = false; static constexpr int MID_T = -1;
    bf16_t *q, *k, *vt, *u, *R, *G1v; float* kmp; const float *qg, *kg, *bgate; const float2* cs;
    __device__ __forceinline__ void operator()(const f32x4 (&acc)[2][2][4][2], const Unit& un, int wr, int wc, int fr, int fq) const {
        const int pn = un.pn, pm = un.pm;
        const int g8 = (16 * wr + fr) * 8, tok0 = pm * 256 + g8, b = pm >> 5, blk = pm & 31, pos0 = (blk << 8) + g8;
        if (pn < 4) {
            const bool isk = pn >= 2; const int hd = (pn & 1) * 4 + wc; const float* gw = isk ? kg : qg; const float sc = isk ? 1.f : 0.125f * 1.4426950408889634f;
            f32x4 gv[2][2], ks[2][2];
#pragma unroll
            for (int bj = 0; bj < 2; ++bj)
#pragma unroll
                for (int n = 0; n < 2; ++n) { gv[bj][n] = *(const f32x4*)(gw + 32 * bj + 8 * fq + 4 * n) * sc; ks[bj][n] = (f32x4){0.f, 0.f, 0.f, 0.f}; }
            float2 cb0[2][4];
#pragma unroll
            for (int n = 0; n < 2; ++n)
#pragma unroll
                for (int e = 0; e < 4; ++e) cb0[n][e] = cs[(size_t)pos0 * 8 + 4 * n + e];
            bf16_t* dst = (isk ? k : q) + ((size_t)(b * 8 + hd) * SEQ + pos0) * 64 + 8 * fq;
            bf16_t* dstk = k + ((size_t)(b * 8 + hd) * SEQ + (size_t)blk * 256) * 64 + (fq >> 1) * 512 + (fq & 1) * 256;
#pragma unroll
            for (int ai = 0; ai < 2; ++ai)
#pragma unroll
                for (int m = 0; m < 4; ++m) {
                    const int slot = 4 * ai + m;
                    float ss = 0.f;
#pragma unroll
                    for (int bj = 0; bj < 2; ++bj)
#pragma unroll
                        for (int n = 0; n < 2; ++n) { const f32x4 v = acc[ai][bj][m][n]; ss += (v[0] * v[0] + v[1] * v[1]) + (v[2] * v[2] + v[3] * v[3]); }
                    ss += __shfl_xor(ss, 16); ss += __shfl_xor(ss, 32);
                    const float rs = rsqrtf(ss * (1.0f / 64.0f) + EPS);
                    f32x4 y[2][2];
#pragma unroll
                    for (int bj = 0; bj < 2; ++bj)
#pragma unroll
                        for (int n = 0; n < 2; ++n) y[bj][n] = acc[ai][bj][m][n] * rs * gv[bj][n];
#pragma unroll
                    for (int n = 0; n < 2; ++n)
#pragma unroll
                        for (int e = 0; e < 4; ++e) {
                            const float2 d = cs[slot * 8 + 4 * n + e], b0 = cb0[n][e]; const float2 c = make_float2(b0.x * d.x - b0.y * d.y, b0.y * d.x + b0.x * d.y);
                            const float own = y[0][n][e], oth = __shfl_xor(own, 16);
                            const float r = (fq == 0) ? (own * c.x - oth * c.y) : (own * c.x + oth * c.y);
                            y[0][n][e] = (fq < 2) ? r : own;
                        }
                    if (isk) {
#pragma unroll
                        for (int bj = 0; bj < 2; ++bj)
#pragma unroll
                            for (int n = 0; n < 2; ++n) ks[bj][n] += y[bj][n];
                    }
#pragma unroll
                    for (int bj = 0; bj < 2; ++bj) { u32x4 w; w.x = cvt_pk_bf16(y[bj][0][0], y[bj][0][1]); w.y = cvt_pk_bf16(y[bj][0][2], y[bj][0][3]); w.z = cvt_pk_bf16(y[bj][1][0], y[bj][1][1]); w.w = cvt_pk_bf16(y[bj][1][2], y[bj][1][3]);
                        if (isk) { const int key = g8 + slot; *(u32x4*)(dstk + (key >> 5) * 2048 + bj * 1024 + (key & 31) * 8) = w; }
                        else *(u32x4*)(dst + slot * 64 + 32 * bj) = w; }
                }
            if (isk) {
#pragma unroll
                for (int bj = 0; bj < 2; ++bj)
#pragma unroll
                    for (int n = 0; n < 2; ++n)
#pragma unroll
                        for (int e = 0; e < 4; ++e) { float v = ks[bj][n][e]; v += __shfl_xor(v, 1); v += __shfl_xor(v, 2); v += __shfl_xor(v, 4); v += __shfl_xor(v, 8); ks[bj][n][e] = v; }
                if (fr == 0) { float* kd = kmp + ((size_t)(((b * 32 + blk) * 8 + hd) * 2 + wr)) * 64 + 8 * fq;
#pragma unroll
                    for (int bj = 0; bj < 2; ++bj)
#pragma unroll
                        for (int n = 0; n < 2; ++n) *(f32x4*)(kd + 32 * bj + 4 * n) = ks[bj][n]; }
            }
        } else if (pn < 6) {
            const int hd = (pn & 1) * 4 + wc; const int g = 16 * wr + fr;
            bf16_t* dst = vt + ((size_t)(b * 8 + hd) * SEQ + (size_t)blk * 256) * 64 + (g >> 2) * 2048 + ((g >> 1) & 1) * 512 + (8 * fq) * 8 + 4 * (g & 1);
#pragma unroll
            for (int bj = 0; bj < 2; ++bj)
#pragma unroll
                for (int n = 0; n < 2; ++n)
#pragma unroll
                    for (int e = 0; e < 4; ++e)
#pragma unroll
                        for (int ai = 0; ai < 2; ++ai) { u32x2 w;
                            w.x = cvt_pk_bf16(acc[ai][bj][0][n][e], acc[ai][bj][1][n][e]); w.y = cvt_pk_bf16(acc[ai][bj][2][n][e], acc[ai][bj][3][n][e]);
                            *(u32x2*)(dst + bj * 1024 + ai * 256 + (4 * n + e) * 8) = w; }
        } else if (pn < 8) {
            bf16_t* dst = u + (size_t)tok0 * 512 + 256 * (pn - 6) + 32 * wc + 8 * fq;
#pragma unroll
            for (int ai = 0; ai < 2; ++ai)
#pragma unroll
                for (int m = 0; m < 4; ++m)
#pragma unroll
                    for (int bj = 0; bj < 2; ++bj) { const f32x4 v0 = acc[ai][bj][m][0], v1 = acc[ai][bj][m][1]; u32x4 w;
                        w.x = cvt_pk_bf16(v0[0], v0[1]); w.y = cvt_pk_bf16(v0[2], v0[3]); w.z = cvt_pk_bf16(v1[0], v1[1]); w.w = cvt_pk_bf16(v1[2], v1[3]);
                        *(u32x4*)(dst + (size_t)(4 * ai + m) * 512 + 128 * bj) = w; }
        } else {
            const int d0 = 128 * (pn - 8) + 32 * wc + 8 * fq;
            f32x4 ba[2], bb[2];
#pragma unroll
            for (int n = 0; n < 2; ++n) { ba[n] = *(const f32x4*)(bgate + d0 + 4 * n); bb[n] = *(const f32x4*)(bgate + 1024 + d0 + 4 * n); }
#pragma unroll
            for (int ai = 0; ai < 2; ++ai)
#pragma unroll
                for (int m = 0; m < 4; ++m) {
                    float rr[8], gg[8];
#pragma unroll
                    for (int n = 0; n < 2; ++n)
#pragma unroll
                        for (int e = 0; e < 4; ++e) { const float a = acc[ai][0][m][n][e] + ba[n][e], bq = acc[ai][1][m][n][e] + bb[n][e];
                            const float pa = 1.f + __builtin_amdgcn_exp2f(a * -1.4426950408889634f), pb = 1.f + __builtin_amdgcn_exp2f(bq * -1.4426950408889634f);
                            const float t = __builtin_amdgcn_rcpf(pa * pb);
                            rr[4 * n + e] = pb * pb * t; gg[4 * n + e] = t * pa; }
                    u32x4 w1, w2;
                    w1.x = cvt_pk_bf16(rr[0], rr[1]); w1.y = cvt_pk_bf16(rr[2], rr[3]); w1.z = cvt_pk_bf16(rr[4], rr[5]); w1.w = cvt_pk_bf16(rr[6], rr[7]);
                    w2.x = cvt_pk_bf16(gg[0], gg[1]); w2.y = cvt_pk_bf16(gg[2], gg[3]); w2.z = cvt_pk_bf16(gg[4], gg[5]); w2.w = cvt_pk_bf16(gg[6], gg[7]);
                    const size_t o = (size_t)(tok0 + 4 * ai + m) * 1024 + d0;
                    *(u32x4*)(R + o) = w1; *(u32x4*)(G1v + o) = w2;
                }
        }
    }
};

struct EpiG2 {
    static constexpr bool PERM = true, APERM = false, MID = true, PRE = false; static constexpr int MID_T = 8;
    const bf16_t *R, *G1v; bf16_t* mixed;
    __device__ __forceinline__ void mid(f32x4 (&acc)[2][2][4][2], const Unit& un, int wr, int wc, int fr, int fq) const {
        unsigned lo_ = (unsigned)((wr * 64 + fr) * 1024 + 32 * wc + 8 * fq); asm volatile("" : "+v"(lo_));
        const bf16_t* src = R + (size_t)(un.pm * 256) * 1024 + un.pn * 256 + lo_;
#pragma unroll
        for (int ai = 0; ai < 2; ++ai) {
            u32x4 w[4][2];
#pragma unroll
            for (int m = 0; m < 4; ++m)
#pragma unroll
                for (int bj = 0; bj < 2; ++bj) w[m][bj] = *(const u32x4*)(src + (size_t)(128 * ai + 16 * m) * 1024 + 128 * bj);
#pragma unroll
            for (int m = 0; m < 4; ++m)
#pragma unroll
                for (int bj = 0; bj < 2; ++bj) { const u32x4 v = w[m][bj];
                    acc[ai][bj][m][0] *= (f32x4){bflo(v.x), bfhi(v.x), bflo(v.y), bfhi(v.y)}; acc[ai][bj][m][1] *= (f32x4){bflo(v.z), bfhi(v.z), bflo(v.w), bfhi(v.w)}; }
            asm volatile("" : "+v"(acc[ai][0][0][0]), "+v"(acc[ai][0][0][1]), "+v"(acc[ai][1][0][0]), "+v"(acc[ai][1][0][1]), "+v"(acc[ai][0][1][0]), "+v"(acc[ai][0][1][1]), "+v"(acc[ai][1][1][0]), "+v"(acc[ai][1][1][1]) :: "memory");
            asm volatile("" : "+v"(acc[ai][0][2][0]), "+v"(acc[ai][0][2][1]), "+v"(acc[ai][1][2][0]), "+v"(acc[ai][1][2][1]), "+v"(acc[ai][0][3][0]), "+v"(acc[ai][0][3][1]), "+v"(acc[ai][1][3][0]), "+v"(acc[ai][1][3][1]) :: "memory");
        }
    }
    __device__ __forceinline__ void operator()(const f32x4 (&acc)[2][2][4][2], const Unit& un, int wr, int wc, int fr, int fq) const {
        const size_t o0 = (size_t)(un.pm * 256 + wr * 64 + fr) * 1024 + un.pn * 256 + 32 * wc + 8 * fq;
#pragma unroll
        for (int ai = 0; ai < 2; ++ai) {
            u32x4 gw[4][2];
#pragma unroll
            for (int m = 0; m < 4; ++m)
#pragma unroll
                for (int bj = 0; bj < 2; ++bj) gw[m][bj] = *(const u32x4*)(G1v + o0 + (size_t)(128 * ai + 16 * m) * 1024 + 128 * bj);
#pragma unroll
            for (int m = 0; m < 4; ++m)
#pragma unroll
                for (int bj = 0; bj < 2; ++bj) { const size_t o = o0 + (size_t)(128 * ai + 16 * m) * 1024 + 128 * bj; const u32x4 w = gw[m][bj];
                    const f32x4 v0 = acc[ai][bj][m][0] * (f32x4){bflo(w.x), bfhi(w.x), bflo(w.y), bfhi(w.y)}, v1 = acc[ai][bj][m][1] * (f32x4){bflo(w.z), bfhi(w.z), bflo(w.w), bfhi(w.w)};
                    u32x4 r; r.x = cvt_pk_bf16(v0[0], v0[1]); r.y = cvt_pk_bf16(v0[2], v0[3]); r.z = cvt_pk_bf16(v1[0], v1[1]); r.w = cvt_pk_bf16(v1[2], v1[3]);
                    *(u32x4*)(mixed + o) = r; }
            asm volatile("" ::: "memory");
        }
    }
};

struct EpiG3 {
    static constexpr bool PERM = true, APERM = false, MID = false, PRE = false; static constexpr int MID_T = -1;
    const bf16_t* xb; const float* rinv; bf16_t* x1b; float* ssq;
    __device__ __forceinline__ void operator()(const f32x4 (&acc)[2][2][4][2], const Unit& un, int wr, int wc, int fr, int fq) const {
        const int row0 = un.pm * 256 + wr * 64 + fr; const int col0 = un.pn * 256 + 32 * wc + 8 * fq;
#pragma unroll
        for (int ai = 0; ai < 2; ++ai)
#pragma unroll
            for (int mh = 0; mh < 2; ++mh) {
                f32x4 xv[2][2][2];
                u32x4 xw[2][2]; float ri[2];
#pragma unroll
                for (int m2 = 0; m2 < 2; ++m2) { ri[m2] = rinv[row0 + 128 * ai + 16 * (2 * mh + m2)];
#pragma unroll
                    for (int bj = 0; bj < 2; ++bj) xw[m2][bj] = *(const u32x4*)(xb + (size_t)(row0 + 128 * ai + 16 * (2 * mh + m2)) * 1024 + col0 + 128 * bj); }
#pragma unroll
                for (int m2 = 0; m2 < 2; ++m2)
#pragma unroll
                    for (int bj = 0; bj < 2; ++bj) { const u32x4 w = xw[m2][bj]; xv[m2][bj][0] = (f32x4){bflo(w.x), bfhi(w.x), bflo(w.y), bfhi(w.y)} * ri[m2]; xv[m2][bj][1] = (f32x4){bflo(w.z), bfhi(w.z), bflo(w.w), bfhi(w.w)} * ri[m2]; }
#pragma unroll
                for (int m2 = 0; m2 < 2; ++m2) { const int m = 2 * mh + m2; const int row = row0 + 128 * ai + 16 * m; float ss = 0.f;
#pragma unroll
                    for (int bj = 0; bj < 2; ++bj) { const size_t o = (size_t)row * 1024 + col0 + 128 * bj;
                        const f32x4 v0 = acc[ai][bj][m][0] + xv[m2][bj][0], v1 = acc[ai][bj][m][1] + xv[m2][bj][1];
                        u32x4 r; r.x = cvt_pk_bf16(v0[0], v0[1]); r.y = cvt_pk_bf16(v0[2], v0[3]); r.z = cvt_pk_bf16(v1[0], v1[1]); r.w = cvt_pk_bf16(v1[2], v1[3]);
                        *(u32x4*)(x1b + o) = r;
                        ss += (v0[0] * v0[0] + v0[1] * v0[1]) + (v0[2] * v0[2] + v0[3] * v0[3]) + (v1[0] * v1[0] + v1[1] * v1[1]) + (v1[2] * v1[2] + v1[3] * v1[3]); }
                    ss += __shfl_xor(ss, 16); ss += __shfl_xor(ss, 32);
                    if (fq == 0) ssq[(size_t)row * 16 + un.pn * 4 + wc] = ss; }
                asm volatile("" ::: "memory");
            }
    }
};

struct EpiG4 {
    static constexpr bool PERM = true, APERM = true, MID = false, PRE = true; static constexpr int MID_T = -1;
    const float *ssq, *cw, *cb; bf16_t* act; float* halo; LAS float* wl;
    __device__ __forceinline__ void pre(const Unit& un, int wr, int wc, int lane) const {
        LAS float* pw = wl + (wr * 4 + wc) * 400 + 128;
        const int c0 = 128 * un.pn + 32 * wc, a = lane >> 3, cc = 4 * (lane & 7); const float* pp = ((a & 3) == 3 ? cb : cw + (size_t)(a & 3) * FF2) + (a >> 2) * FF + c0 + cc;
        __builtin_amdgcn_global_load_lds((const unsigned*)pp, (LAS unsigned*)pw, 16, 0, 0);
    }
    __device__ __forceinline__ void operator()(f32x4 (&acc)[2][2][4][2], const Unit& un, int wr, int wc, int fr, int fq) const {
        const int lane = fr + 16 * fq;
        LAS float* rsl = wl + (wr * 4 + wc) * 400;
        LAS float* pw = rsl + 128;
        LAS int* tag = (LAS int*)(rsl + 384);
        const int tokw = un.pm * 256 + 128 * wr, c0 = 128 * un.pn + 32 * wc;
        if (*tag != un.pm) {
            const f32x4* s0 = (const f32x4*)(ssq + (size_t)(tokw + lane) * 16); const f32x4* s1 = (const f32x4*)(ssq + (size_t)(tokw + 64 + lane) * 16);
            const f32x4 x0 = s0[0] + s0[1] + s0[2] + s0[3], x1 = s1[0] + s1[1] + s1[2] + s1[3];
            rsl[lane] = rsqrtf(((x0[0] + x0[1]) + (x0[2] + x0[3])) * (1.0f / 1024.0f) + EPS); rsl[64 + lane] = rsqrtf(((x1[0] + x1[1]) + (x1[2] + x1[3])) * (1.0f / 1024.0f) + EPS);
            if (lane == 0) *tag = un.pm;
        }
        asm volatile("s_waitcnt vmcnt(0)" ::: "memory");
        const int tok0 = un.pm * 256 + (16 * wr + fr) * 8, grp = un.pm * 2 + wr;
        {   const f32x4 r0 = *(const LAS f32x4*)(rsl + 8 * fr), r1 = *(const LAS f32x4*)(rsl + 8 * fr + 4);
#pragma unroll
            for (int s = 0; s < 8; ++s) { const float rs = (s < 4) ? r0[s & 3] : r1[s & 3];
#pragma unroll
                for (int bj = 0; bj < 2; ++bj)
#pragma unroll
                    for (int n = 0; n < 2; ++n) acc[s >> 2][bj][s & 3][n] *= rs; } }
#pragma unroll
        for (int n = 0; n < 2; ++n) {
            const int cg0 = c0 + 8 * fq + 4 * n;
            const int np0 = 256 * un.pn + 32 * wc + 8 * fq + 4 * n;
            typedef float f32x2 __attribute__((ext_vector_type(2)));
            unsigned pk[8][2];
#pragma unroll
            for (int ep = 0; ep < 2; ++ep) {
                f32x2 prm[8];
#pragma unroll
                for (int a = 0; a < 8; ++a) prm[a] = *(const LAS f32x2*)(pw + a * 32 + 8 * fq + 4 * n + 2 * ep);
                f32x2 ug[8], uv[8];
#pragma unroll
                for (int s = 0; s < 8; ++s) { ug[s] = (f32x2){acc[s >> 2][0][s & 3][n][2 * ep], acc[s >> 2][0][s & 3][n][2 * ep + 1]}; uv[s] = (f32x2){acc[s >> 2][1][s & 3][n][2 * ep], acc[s >> 2][1][s & 3][n][2 * ep + 1]}; }
                f32x2 pg1, pg2, pv1, pv2;
#pragma unroll
                for (int e2 = 0; e2 < 2; ++e2) {
                    pg1[e2] = __shfl_up(ug[7][e2], 1); pg2[e2] = __shfl_up(ug[6][e2], 1); pv1[e2] = __shfl_up(uv[7][e2], 1); pv2[e2] = __shfl_up(uv[6][e2], 1);
                }
                if (fr == 0) { float* h = halo + ((size_t)grp * 4) * FF2 + np0 + 2 * ep; *(f32x2*)h = ug[0]; *(f32x2*)(h + 128) = uv[0]; *(f32x2*)(h + FF2) = ug[1]; *(f32x2*)(h + FF2 + 128) = uv[1]; }
                if (fr == 15) { float* h = halo + ((size_t)grp * 4 + 2) * FF2 + np0 + 2 * ep; *(f32x2*)h = ug[6]; *(f32x2*)(h + 128) = uv[6]; *(f32x2*)(h + FF2) = ug[7]; *(f32x2*)(h + FF2 + 128) = uv[7]; }
#pragma unroll
                for (int s = 0; s < 8; ++s) {
                    const f32x2 g1 = (s >= 1) ? ug[s >= 1 ? s - 1 : 0] : pg1, v1 = (s >= 1) ? uv[s >= 1 ? s - 1 : 0] : pv1;
                    const f32x2 g2 = (s >= 2) ? ug[s >= 2 ? s - 2 : 0] : (s == 1 ? pg1 : pg2), v2 = (s >= 2) ? uv[s >= 2 ? s - 2 : 0] : (s == 1 ? pv1 : pv2);
                    const f32x2 cgv = prm[0] * g2 + prm[1] * g1 + prm[2] * ug[s] + prm[3];
                    const f32x2 cvv = prm[4] * v2 + prm[5] * v1 + prm[6] * uv[s] + prm[7];
                    const f32x2 ex = cgv * (-1.4426950408889634f);
                    f32x2 den; den[0] = 1.f + __builtin_amdgcn_exp2f(ex[0]); den[1] = 1.f + __builtin_amdgcn_exp2f(ex[1]);
                    f32x2 rc; rc[0] = __builtin_amdgcn_rcpf(den[0]); rc[1] = __builtin_amdgcn_rcpf(den[1]);
                    const f32x2 res = cgv * rc * cvv;
                    pk[s][ep] = cvt_pk_bf16(res[0], res[1]);
                }
            }
#pragma unroll
            for (int s = 0; s < 8; ++s) { u32x2 w; w.x = pk[s][0]; w.y = pk[s][1];
                if (s >= 2 || fr != 0) *(u32x2*)(act + (size_t)(tok0 + s) * FF + cg0) = w; }
        }
    }
};

struct EpiG5 {
    static constexpr bool PERM = true, APERM = false, MID = false, PRE = false; static constexpr int MID_T = -1;
    const bf16_t* x1b; float* out;
    __device__ __forceinline__ void operator()(const f32x4 (&acc)[2][2][4][2], const Unit& un, int wr, int wc, int fr, int fq) const {
        const size_t o0 = (size_t)(un.pm * 256 + wr * 64 + fr) * 1024 + un.pn * 256 + 32 * wc + 8 * fq;
#pragma unroll
        for (int ai = 0; ai < 2; ++ai) {
            u32x4 xr[4][2];
#pragma unroll
            for (int m = 0; m < 4; ++m)
#pragma unroll
                for (int bj = 0; bj < 2; ++bj) xr[m][bj] = *(const u32x4*)(x1b + o0 + (size_t)(128 * ai + 16 * m) * 1024 + 128 * bj);
#pragma unroll
            for (int m = 0; m < 4; ++m)
#pragma unroll
                for (int bj = 0; bj < 2; ++bj) { const size_t o = o0 + (size_t)(128 * ai + 16 * m) * 1024 + 128 * bj; const u32x4 w = xr[m][bj];
                    *(f32x4*)(out + o) = acc[ai][bj][m][0] + (f32x4){bflo(w.x), bfhi(w.x), bflo(w.y), bfhi(w.y)}; *(f32x4*)(out + o + 4) = acc[ai][bj][m][1] + (f32x4){bflo(w.z), bfhi(w.z), bflo(w.w), bfhi(w.w)}; }
            asm volatile("" ::: "memory");
        }
    }
};

template <bool AP_> struct EpiNull {
    static constexpr bool PERM = true, APERM = AP_, MID = false, PRE = false; static constexpr int MID_T = -1;
    float* sink;
    __device__ __forceinline__ void operator()(const f32x4 (&acc)[2][2][4][2], const Unit& un, int wr, int wc, int fr, int fq) const {
        float s = 0.f;
#pragma unroll
        for (int a = 0; a < 2; ++a)
#pragma unroll
            for (int b = 0; b < 2; ++b)
#pragma unroll
                for (int m = 0; m < 4; ++m)
#pragma unroll
                    for (int n = 0; n < 2; ++n) s += acc[a][b][m][n][0] + acc[a][b][m][n][1] + acc[a][b][m][n][2] + acc[a][b][m][n][3];
        if (s == 12345.678f) sink[0] = s;
    }
};
__device__ __forceinline__ int colmap_in(int np) {
    const int pn = np >> 8, p = np & 255;
    if (pn < 6) { const int bj = p >> 7, wc = (p >> 5) & 3, j = p & 31; return 256 * pn + 64 * wc + 32 * bj + j; }
    if (pn < 8) return np;
    return 2048 + 1024 * (p >> 7) + 128 * (pn - 8) + (p & 127);
}
__device__ __forceinline__ int colmap_up(int np) { const int pn = np >> 8, p = np & 255; return FF * (p >> 7) + 128 * pn + (p & 127); }

struct TrJob { const float* src; const float* scale; bf16_t* dst; int Nsrc, ldd, k0, n0, mode; };
__device__ __forceinline__ TrJob tr_decode(const Params& p, int t) {
    unsigned char* ws = p.ws; TrJob j;
    if (t < 1024) { j = TrJob{p.w_in, p.norm_mix_g, (bf16_t*)(ws + WS_WIN), INW, 1024, (t & 15) * 64, (t >> 4) * 64, 1}; }
    else if (t < 1152) { const int u = t - 1024; j = TrJob{p.w_ba, nullptr, (bf16_t*)(ws + WS_W2), 1024, 1024, (u & 7) * 64, (u >> 3) * 64, 0}; }
    else if (t < 1408) { const int u = t - 1152; j = TrJob{p.w_out, nullptr, (bf16_t*)(ws + WS_WO), 1024, 1024, (u & 15) * 64, (u >> 4) * 64, 0}; }
    else if (t < 2816) { const int u = t - 1408; j = TrJob{p.w_up, p.norm_ffn_g, (bf16_t*)(ws + WS_WUP), FF2, 1024, (u & 15) * 64, (u >> 4) * 64, 2}; }
    else { const int u = t - 2816; j = TrJob{p.w_down, nullptr, (bf16_t*)(ws + WS_WD), 1024, FF, (u % 44) * 64, (u / 44) * 64, 0}; }
    return j;
}
__device__ __forceinline__ void tr_load(const TrJob& j, float (&v)[8]) {
    const int tid = threadIdx.x, nl = tid & 63, kl = tid >> 6; const int np = j.n0 + nl; const int sc = j.mode == 1 ? colmap_in(np) : (j.mode == 2 ? colmap_up(np) : np);
#pragma unroll
    for (int i = 0; i < 8; ++i) { const int k = j.k0 + kl + 8 * i; v[i] = j.src[(size_t)k * j.Nsrc + sc]; }
    if (j.scale) {
#pragma unroll
        for (int i = 0; i < 8; ++i) v[i] *= j.scale[j.k0 + kl + 8 * i]; }
}
__device__ __forceinline__ void tr_put(LAS float* tile, const float (&v)[8]) { const int tid = threadIdx.x, nl = tid & 63, kl = tid >> 6;
#pragma unroll
    for (int i = 0; i < 8; ++i) tile[nl * 65 + kl + 8 * i] = v[i]; }
__device__ __forceinline__ void tr_store(const LAS float* tile, const TrJob& j) { const int tid = threadIdx.x, nl = tid >> 3, kl = (tid & 7) * 8; const LAS float* tp = tile + nl * 65 + kl; u32x4 w;
    w.x = cvt_pk_bf16(tp[0], tp[1]); w.y = cvt_pk_bf16(tp[2], tp[3]); w.z = cvt_pk_bf16(tp[4], tp[5]); w.w = cvt_pk_bf16(tp[6], tp[7]);
    *(u32x4*)(j.dst + (size_t)(j.n0 + nl) * j.ldd + j.k0 + kl) = w; }

__device__ __forceinline__ void sincos_d(double x, double& s, double& c) {
    const double x2 = x * x; double ts = x, tc = 1.0; s = x; c = 1.0;
#pragma unroll 1
    for (int i = 1; i <= 14; ++i) { tc *= -x2 / (double)((2 * i - 1) * (2 * i)); ts *= -x2 / (double)((2 * i) * (2 * i + 1)); c += tc; s += ts; }
}

__device__ void p0_prep(const Params& p, LAS unsigned char* lds) {
    const int tid = threadIdx.x, G = gridDim.x, bid = blockIdx.x, wave = tid >> 6, lane = tid & 63;
    unsigned char* ws = p.ws;
    { bf16_t* xb = (bf16_t*)(ws + WS_B);
      for (int row0 = (bid * 8 + wave) * 4; row0 < T; row0 += G * 32) {
          f32x4 v[4][4]; float ss[4];
#pragma unroll
          for (int rr = 0; rr < 4; ++rr) { const f32x4* xr = (const f32x4*)(p.x + (size_t)(row0 + rr) * 1024);
#pragma unroll
              for (int i = 0; i < 4; ++i) v[rr][i] = __builtin_nontemporal_load(xr + lane + 64 * i); }
#pragma unroll
          for (int rr = 0; rr < 4; ++rr) { float a = 0.f;
#pragma unroll
              for (int i = 0; i < 4; ++i) a += (v[rr][i][0] * v[rr][i][0] + v[rr][i][1] * v[rr][i][1]) + (v[rr][i][2] * v[rr][i][2] + v[rr][i][3] * v[rr][i][3]);
              ss[rr] = a; }
#pragma unroll
          for (int o = 32; o >= 1; o >>= 1) {
#pragma unroll
              for (int rr = 0; rr < 4; ++rr) ss[rr] += __shfl_xor(ss[rr], o); }
#pragma unroll
          for (int rr = 0; rr < 4; ++rr) { const float rs = rsqrtf(ss[rr] * (1.0f / 1024.0f) + EPS); if (lane == 0) ((float*)(ws + WS_RINV))[row0 + rr] = 1.0f / rs;
#pragma unroll
              for (int i = 0; i < 4; ++i) { u32x2 w; w.x = cvt_pk_bf16(v[rr][i][0] * rs, v[rr][i][1] * rs); w.y = cvt_pk_bf16(v[rr][i][2] * rs, v[rr][i][3] * rs); *(u32x2*)(xb + (size_t)(row0 + rr) * 1024 + (lane + 64 * i) * 4) = w; } }
      } }
    { LAS float* tile0 = (LAS float*)lds;
      for (int t = bid; t < 3520; t += 4 * G) {
          TrJob j[4]; float v[4][8]; bool on[4];
#pragma unroll
          for (int q = 0; q < 4; ++q) { on[q] = (t + q * G) < 3520; j[q] = tr_decode(p, on[q] ? t + q * G : t); tr_load(j[q], v[q]); }
          __syncthreads();
#pragma unroll
          for (int q = 0; q < 4; ++q) tr_put(tile0 + q * (64 * 65), v[q]);
          __syncthreads();
#pragma unroll
          for (int q = 0; q < 4; ++q) if (on[q]) tr_store(tile0 + q * (64 * 65), j[q]);
      }
      __syncthreads();
      bf16_t* W2T = (bf16_t*)(ws + WS_W2);
      { LAS float* wbl = (LAS float*)lds;
        for (int n0 = 4 * bid; n0 < 1024; n0 += 4 * G) {
            *(LAS f32x4*)(wbl + 4 * tid) = *(const f32x4*)(p.w_bp + (size_t)tid * 1024 + n0);
            __syncthreads();
            const int kk = tid, g = kk >> 7; const f32x4* wp = (const f32x4*)(p.w_pool + (size_t)kk * 128); const f32x4* sc = (const f32x4*)(p.pool_scale + g * 128);
            f32x4 acc4 = {0.f, 0.f, 0.f, 0.f};
#pragma unroll 8
            for (int d4 = 0; d4 < 32; ++d4) { const f32x4 w = wp[d4] * sc[d4];
#pragma unroll
                for (int e = 0; e < 4; ++e) acc4 += w[e] * *(const LAS f32x4*)(wbl + 4 * (g * 128 + 4 * d4 + e)); }
#pragma unroll
            for (int e = 0; e < 4; ++e) W2T[(size_t)(n0 + e) * 1024 + 512 + kk] = (bf16_t)(cvt_pk_bf16(acc4[e], 0.f) & 0xffffu);
            __syncthreads();
        } }
      float2* cs = (float2*)(ws + WS_CS);
      for (int idx = bid * 512 + tid; idx < SEQ * 8; idx += G * 512) {
          const int pos = idx >> 3, j = idx & 7;
          const float invf = (j == 0) ? 1.0f : (j == 1) ? 0.1939227432012558f : (j == 2) ? 0.03760603070259094f : (j == 3) ? 0.007292664609849453f : (j == 4) ? 0.0014142135623842478f : (j == 5) ? 0.00027424818836152554f : (j == 6) ? 5.318296098266728e-05f : 1.0313386155758053e-05f;
          const float ang = (float)pos * invf; const double xd = (double)ang; const double kq = rint(xd * 0.15915494309189535); const double r = xd - kq * 6.283185307179586476925;
          double s, c; sincos_d(r, s, c); cs[idx] = make_float2((float)c, (float)s);
      }
    }
}

constexpr int AT_MASK = 0, AT_LIST = 1024, AT_CNT = 9472, AT_TASK = 9600, AT_CTL = 10112, AT_LP = 10240, AT_OP = 14336, AT_OPS = 520;
#define MFMA32(a, b, c) __builtin_amdgcn_mfma_f32_32x32x16_bf16((a), (b), (c), 0, 0, 0)

struct Top3 { float v1, v2, v3; int i1, i2, i3; };
__device__ __forceinline__ void top3_ins(Top3& t, float s, int j) {
    const bool b1 = (s > t.v1) || (s == t.v1 && j < t.i1), b2 = (s > t.v2) || (s == t.v2 && j < t.i2), b3 = (s > t.v3) || (s == t.v3 && j < t.i3);
    if (b1) { t.v3 = t.v2; t.i3 = t.i2; t.v2 = t.v1; t.i2 = t.i1; t.v1 = s; t.i1 = j; }
    else if (b2) { t.v3 = t.v2; t.i3 = t.i2; t.v2 = s; t.i2 = j; }
    else if (b3) { t.v3 = s; t.i3 = j; }
}

template <int FL> __device__ __forceinline__ void attn_item(const Params& p, LAS unsigned char* lds, int bh, int i, bf16_t* apbase) {
    const int tid = threadIdx.x, wave = __builtin_amdgcn_readfirstlane(tid >> 6), lane = tid & 63;
    unsigned char* ws = p.ws;
    LAS unsigned char* OP = lds + AT_OP; LAS float* Lpart = (LAS float*)(lds + AT_LP);
    LAS unsigned* MASK = (LAS unsigned*)(lds + AT_MASK); LAS unsigned char* LIST = (LAS unsigned char*)(lds + AT_LIST); LAS int* CNT = (LAS int*)(lds + AT_CNT);
    LAS unsigned short* TASK = (LAS unsigned short*)(lds + AT_TASK); LAS int* CTL = (LAS int*)(lds + AT_CTL);
    const int b = bh >> 3, h = bh & 7;
    const bf16_t* qb = (const bf16_t*)(ws + WS_Q) + ((size_t)bh * SEQ + (size_t)i * 256) * 64;
    const bf16_t* kb = (const bf16_t*)(ws + WS_K) + (size_t)bh * SEQ * 64;
    const bf16_t* vb = (const bf16_t*)(ws + WS_VT) + (size_t)bh * 32 * 64 * 256;
    const float* kmp = (const float*)(ws + WS_KMP);
    const int r = lane & 31, hh = lane >> 5;
    __syncthreads();
    if (i > 0) {
        f32x16 st;
#pragma unroll
        for (int e = 0; e < 16; ++e) st[e] = 0.f;
        const float* kp = kmp + ((size_t)(((b * 32 + r) * 8 + h) * 2)) * 64 + 8 * hh;
        f32x4 ka[4][4]; bf16x8 qr[4];
#pragma unroll
        for (int s = 0; s < 4; ++s) { qr[s] = *(const bf16x8*)(qb + (size_t)(32 * wave + r) * 64 + 16 * s + 8 * hh);
            if (r < i) { ka[s][0] = *(const f32x4*)(kp + 16 * s); ka[s][1] = *(const f32x4*)(kp + 64 + 16 * s); ka[s][2] = *(const f32x4*)(kp + 16 * s + 4); ka[s][3] = *(const f32x4*)(kp + 64 + 16 * s + 4); }
            else { ka[s][0] = ka[s][1] = ka[s][2] = ka[s][3] = (f32x4){0.f, 0.f, 0.f, 0.f}; } }
#pragma unroll
        for (int s = 0; s < 4; ++s) {
            const f32x4 a0 = (ka[s][0] + ka[s][1]) * (1.0f / 256.0f), a1 = (ka[s][2] + ka[s][3]) * (1.0f / 256.0f);
            u32x4 hi; hi.x = cvt_pk_bf16(a0[0], a0[1]); hi.y = cvt_pk_bf16(a0[2], a0[3]); hi.z = cvt_pk_bf16(a1[0], a1[1]); hi.w = cvt_pk_bf16(a1[2], a1[3]);
            u32x4 lo; lo.x = cvt_pk_bf16(a0[0] - bflo(hi.x), a0[1] - bfhi(hi.x)); lo.y = cvt_pk_bf16(a0[2] - bflo(hi.y), a0[3] - bfhi(hi.y));
            lo.z = cvt_pk_bf16(a1[0] - bflo(hi.z), a1[1] - bfhi(hi.z)); lo.w = cvt_pk_bf16(a1[2] - bflo(hi.w), a1[3] - bfhi(hi.w));
            st = MFMA32(__builtin_bit_cast(bf16x8, hi), qr[s], st); st = MFMA32(__builtin_bit_cast(bf16x8, lo), qr[s], st);
        }
        Top3 t; t.v1 = t.v2 = t.v3 = -INFINITY; t.i1 = t.i2 = t.i3 = 64;
#pragma unroll
        for (int e = 0; e < 16; ++e) { const int j = (e & 3) + 8 * (e >> 2) + 4 * hh; if (j < i) top3_ins(t, st[e], j); }
        const float pv1 = __shfl_xor(t.v1, 32), pv2 = __shfl_xor(t.v2, 32), pv3 = __shfl_xor(t.v3, 32); const int pi1 = __shfl_xor(t.i1, 32), pi2 = __shfl_xor(t.i2, 32), pi3 = __shfl_xor(t.i3, 32);
        if (pi1 < 64) top3_ins(t, pv1, pi1); if (pi2 < 64) top3_ins(t, pv2, pi2); if (pi3 < 64) top3_ins(t, pv3, pi3);
        unsigned mk = 0u; if (t.i1 < 64) mk |= 1u << t.i1; if (t.i2 < 64) mk |= 1u << t.i2; if (t.i3 < 64) mk |= 1u << t.i3;
        if (hh == 0) MASK[32 * wave + r] = mk;
    }
    __syncthreads();
    for (int j = wave; j < i; j += 8) {
        int base = 0;
        for (int c = 0; c < 4; ++c) { const int ql = 64 * c + lane; const bool bit = (MASK[ql] >> j) & 1u; const unsigned long long bal = __ballot(bit);
            const int pre = __popcll(bal & ((1ull << lane) - 1ull)); if (bit) LIST[j * 256 + base + pre] = (unsigned char)ql; base += __popcll(bal); }
        if (lane == 0) CNT[j] = base;
    }
    __syncthreads();
    if (wave == 0) {
        const int nq = (lane < i) ? ((CNT[lane] + 31) >> 5) : 0; int inc = nq;
#pragma unroll
        for (int o = 1; o < 64; o <<= 1) { const int v = __shfl_up(inc, o); if (lane >= o) inc += v; }
        const int st0 = inc - nq, tot = __shfl(inc, 63);
        for (int t = 0; t < nq; ++t) TASK[st0 + t] = (unsigned short)((lane << 8) | t);
        if (lane < 8) TASK[tot + lane] = (unsigned short)((32 << 8) | (7 - lane));
        if (lane == 63) { CTL[0] = 8 + tot; CTL[1] = 0; }
    }
    __syncthreads();
    const int ntask = (FL & 1) ? 0 : CTL[0];
    for (;;) {
        int t = 0; if (lane == 0) t = __hip_atomic_fetch_add(&CTL[1], 1, __ATOMIC_RELAXED, __HIP_MEMORY_SCOPE_WORKGROUP);
        t = __builtin_amdgcn_readfirstlane(t);
        if (t >= ntask) break;
        const int tk = TASK[t], jb = tk >> 8, tile = tk & 255; const bool own = jb == 32; const int j = own ? i : jb;
        const int slot = 32 * tile + r; const int nj = own ? 256 : CNT[j]; const bool valid = slot < nj;
        const int ql = own ? slot : (valid ? (int)LIST[j * 256 + slot] : 0);
        const bf16_t* kj = kb + (size_t)j * 16384 + lane * 8;
        const bf16_t* vj = vb + (size_t)j * 16384 + lane * 8;
        const int nkt = own ? tile + 1 : 8;
        bf16x8 qf[4];
#pragma unroll
        for (int s = 0; s < 4; ++s) qf[s] = *(const bf16x8*)(qb + (size_t)ql * 64 + 16 * s + 8 * hh);
        f32x16 o0, o1; float lsum = 0.f;
#pragma unroll
        for (int e = 0; e < 16; ++e) { o0[e] = 0.f; o1[e] = 0.f; }
#define AT_LOAD(K_, V_, kt_) do { const int c_ = ((kt_) < nkt) ? (kt_) : nkt - 1; \
        _Pragma("unroll") for (int s = 0; s < 4; ++s) K_[s] = *(const bf16x8*)(kj + c_ * 2048 + 512 * s); \
        _Pragma("unroll") for (int dh = 0; dh < 2; ++dh) _Pragma("unroll") for (int s2 = 0; s2 < 2; ++s2) V_[dh][s2] = *(const bf16x8*)(vj + c_ * 2048 + dh * 1024 + 512 * s2); } while (0)
#define AT_COMPUTE(K_, V_, kt_) do { f32x16 st; \
        _Pragma("unroll") for (int e = 0; e < 16; ++e) st[e] = 0.f; \
        _Pragma("unroll") for (int s = 0; s < 4; ++s) st = MFMA32(K_[s], qf[s], st); \
        const bool diag = own && ((kt_) == tile); float pe[16]; \
        _Pragma("unroll") for (int e = 0; e < 16; ++e) { float pv = __builtin_amdgcn_exp2f(st[e]); const int krow = (e & 3) + 8 * (e >> 2) + 4 * hh; if (diag && krow > r) pv = 0.f; pe[e] = pv; lsum += pv; } \
        bf16x8 pb[2]; \
        _Pragma("unroll") for (int s2 = 0; s2 < 2; ++s2) { u32x4 w; w.x = cvt_pk_bf16(pe[8 * s2], pe[8 * s2 + 1]); w.y = cvt_pk_bf16(pe[8 * s2 + 2], pe[8 * s2 + 3]); w.z = cvt_pk_bf16(pe[8 * s2 + 4], pe[8 * s2 + 5]); w.w = cvt_pk_bf16(pe[8 * s2 + 6], pe[8 * s2 + 7]); pb[s2] = __builtin_bit_cast(bf16x8, w); } \
        _Pragma("unroll") for (int s2 = 0; s2 < 2; ++s2) { o0 = MFMA32(V_[0][s2], pb[s2], o0); o1 = MFMA32(V_[1][s2], pb[s2], o1); } } while (0)
        bf16x8 kA[4], vA[2][2], kB[4], vB[2][2], kC[4], vC[2][2];
        AT_LOAD(kA, vA, 0); AT_LOAD(kB, vB, 1);
        for (int kt = 0; kt < nkt; kt += 3) {
            AT_LOAD(kC, vC, kt + 2); AT_COMPUTE(kA, vA, kt);
            if (kt + 1 < nkt) { AT_LOAD(kA, vA, kt + 3); AT_COMPUTE(kB, vB, kt + 1); }
            if (kt + 2 < nkt) { AT_LOAD(kB, vB, kt + 4); AT_COMPUTE(kC, vC, kt + 2); }
        }
#undef AT_LOAD
#undef AT_COMPUTE
        lsum += __shfl_xor(lsum, 32);
        if (valid && !(FL & 2)) {
            const int pr = own ? 3 : __popc(MASK[ql] & ((1u << j) - 1u));
            LAS unsigned char* op = OP + ql * AT_OPS + pr * 128 + 8 * hh;
#pragma unroll
            for (int g4 = 0; g4 < 4; ++g4) { u32x2 w0, w1; w0.x = cvt_pk_bf16(o0[4 * g4], o0[4 * g4 + 1]); w0.y = cvt_pk_bf16(o0[4 * g4 + 2], o0[4 * g4 + 3]); w1.x = cvt_pk_bf16(o1[4 * g4], o1[4 * g4 + 1]); w1.y = cvt_pk_bf16(o1[4 * g4 + 2], o1[4 * g4 + 3]);
                *(LAS u32x2*)(op + 16 * g4) = w0; *(LAS u32x2*)(op + 64 + 16 * g4) = w1; }
            if (hh == 0) Lpart[ql * 4 + pr] = lsum;
        }
    }
    __syncthreads();
    { const int ql = tid >> 1, half = tid & 1; const int np = (i > 0) ? __popc(MASK[ql]) : 0;
      const LAS unsigned char* op = OP + ql * AT_OPS + 64 * half; const LAS float* lp = Lpart + ql * 4;
      float a[32]; float l = 0.f;
#pragma unroll
      for (int c = 0; c < 32; ++c) a[c] = 0.f;
#pragma unroll
      for (int pr = 0; pr < 4; ++pr) { const bool on = (pr == 3) || (pr < np);
          const float lv = lp[pr]; l += on ? lv : 0.f;
#pragma unroll
          for (int c = 0; c < 8; ++c) { const u32x2 w = *(const LAS u32x2*)(op + pr * 128 + 8 * c);
              a[4 * c] += on ? bflo(w.x) : 0.f; a[4 * c + 1] += on ? bfhi(w.x) : 0.f; a[4 * c + 2] += on ? bflo(w.y) : 0.f; a[4 * c + 3] += on ? bfhi(w.y) : 0.f; } }
      const float inv = 1.0f / l;
      bf16_t* dst = apbase + ((size_t)b * SEQ + (size_t)i * 256 + ql) * 1024 + h * 64 + 32 * half;
#pragma unroll
      for (int c = 0; c < 4; ++c) { u32x4 w; w.x = cvt_pk_bf16(a[8 * c] * inv, a[8 * c + 1] * inv); w.y = cvt_pk_bf16(a[8 * c + 2] * inv, a[8 * c + 3] * inv);
          w.z = cvt_pk_bf16(a[8 * c + 4] * inv, a[8 * c + 5] * inv); w.w = cvt_pk_bf16(a[8 * c + 6] * inv, a[8 * c + 7] * inv); *(u32x4*)(dst + 8 * c) = w; } }
}

__device__ __forceinline__ void acc8(float (&sum)[8], const u32x4& x, float sg) {
    sum[0] += sg * bflo(x.x); sum[1] += sg * bfhi(x.x); sum[2] += sg * bflo(x.y); sum[3] += sg * bfhi(x.y); sum[4] += sg * bflo(x.z); sum[5] += sg * bfhi(x.z); sum[6] += sg * bflo(x.w); sum[7] += sg * bfhi(x.w); }
__device__ __forceinline__ void pool_unit(const Params& p, int unit, bf16_t* ap) {
    const int tid = threadIdx.x, wave = tid >> 6, lane = tid & 63;
    const bf16_t* u = (const bf16_t*)(p.ws + WS_U);
    const int g = lane >> 4, w = 2 << g, t0 = unit * 64 + wave * 8, pos0 = t0 & (SEQ - 1);
    const bf16_t* ub = u + (size_t)t0 * 512 + lane * 8;
    const u32x4 zero = {0u, 0u, 0u, 0u};
    u32x4 xc[8], yr[8];
#pragma unroll
    for (int s = 0; s < 8; ++s) xc[s] = *(const u32x4*)(ub + s * 512);
#pragma unroll
    for (int s = 0; s < 8; ++s) yr[s] = (pos0 + s - w >= 0) ? *(const u32x4*)(ub + (s - w) * 512) : zero;
    float sum[8];
#pragma unroll
    for (int c = 0; c < 8; ++c) sum[c] = 0.f;
#pragma unroll
    for (int hb = 0; hb < 2; ++hb) {
        u32x4 h[8];
#pragma unroll
        for (int k = 0; k < 8; ++k) { const int d = 1 + 8 * hb + k; h[k] = (d < w && pos0 - d >= 0) ? *(const u32x4*)(ub - d * 512) : zero; }
#pragma unroll
        for (int k = 0; k < 8; ++k) acc8(sum, h[k], 1.f);
    }
    { const u32x4 y = yr[0]; acc8(sum, y, 1.f); }
#pragma unroll
    for (int s = 0; s < 8; ++s) {
        acc8(sum, xc[s], 1.f); acc8(sum, yr[s], -1.f);
        const int pos = pos0 + s; const float inv = 1.0f / (float)((pos + 1 < w) ? pos + 1 : w);
        const u32x4 x = xc[s]; const float cur[8] = {bflo(x.x), bfhi(x.x), bflo(x.y), bfhi(x.y), bflo(x.z), bfhi(x.z), bflo(x.w), bfhi(x.w)};
        u32x4 o; o.x = cvt_pk_bf16(sum[0] * inv - cur[0], sum[1] * inv - cur[1]); o.y = cvt_pk_bf16(sum[2] * inv - cur[2], sum[3] * inv - cur[3]);
        o.z = cvt_pk_bf16(sum[4] * inv - cur[4], sum[5] * inv - cur[5]); o.w = cvt_pk_bf16(sum[6] * inv - cur[6], sum[7] * inv - cur[7]);
        *(u32x4*)(ap + (size_t)(t0 + s) * 1024 + 512 + lane * 8) = o;
    }
}

__device__ void fixup_panel(const Params& p, int pm) {
    const float* halo = (const float*)(p.ws + WS_HALO); bf16_t* act = (bf16_t*)(p.ws + WS_ACT);
    const float* cw = p.conv_w; const float* cb = p.conv_b;
    const int g0 = 2 * pm; const bool first = (g0 & 63) == 0;
    const float* hm = halo + (size_t)(g0 - 1) * 4 * FF2; const float* h0 = halo + (size_t)g0 * 4 * FF2; const float* h1 = h0 + 4 * FF2;
#pragma unroll 2
    for (int c = threadIdx.x; c < FF; c += 512) {
        const int npg = 256 * (c >> 7) + (c & 127), npv = npg + 128;
        const float w0g = cw[c], w1g = cw[FF2 + c], w2g = cw[2 * FF2 + c], bg = cb[c], w0v = cw[FF + c], w1v = cw[FF2 + FF + c], w2v = cw[2 * FF2 + FF + c], bv = cb[FF + c];
        const float gm2 = first ? 0.f : hm[2 * FF2 + npg], gm1 = first ? 0.f : hm[3 * FF2 + npg], vm2 = first ? 0.f : hm[2 * FF2 + npv], vm1 = first ? 0.f : hm[3 * FF2 + npv];
        const float ga0 = h0[npg], ga1 = h0[FF2 + npg], ga2 = h0[2 * FF2 + npg], ga3 = h0[3 * FF2 + npg], va0 = h0[npv], va1 = h0[FF2 + npv], va2 = h0[2 * FF2 + npv], va3 = h0[3 * FF2 + npv];
        const float gb0 = h1[npg], gb1 = h1[FF2 + npg], vb0 = h1[npv], vb1 = h1[FF2 + npv];
        float cg[4], cv[4];
        cg[0] = w0g * gm2 + w1g * gm1 + w2g * ga0 + bg; cv[0] = w0v * vm2 + w1v * vm1 + w2v * va0 + bv;
        cg[1] = w0g * gm1 + w1g * ga0 + w2g * ga1 + bg; cv[1] = w0v * vm1 + w1v * va0 + w2v * va1 + bv;
        cg[2] = w0g * ga2 + w1g * ga3 + w2g * gb0 + bg; cv[2] = w0v * va2 + w1v * va3 + w2v * vb0 + bv;
        cg[3] = w0g * ga3 + w1g * gb0 + w2g * gb1 + bg; cv[3] = w0v * va3 + w1v * vb0 + w2v * vb1 + bv;
#pragma unroll
        for (int q = 0; q < 4; ++q) { const float a = cg[q] * __builtin_amdgcn_rcpf(1.f + __expf(-cg[q])) * cv[q];
            act[(size_t)((g0 + (q >> 1)) * 128 + (q & 1)) * FF + c] = (bf16_t)(cvt_pk_bf16(a, 0.f) & 0xffffu); }
    }
}

#define XB_TMO      128
#define XB_XCNT(j)  (256  + 64 * (j))
#define XB_XSUB(j)  (1280 + 64 * (j))
#define XB_XGEN(j)  (2304 + 64 * (j))
#define XB_TOP      3328
#define XB_TOPGEN   3392
#define XCD_BAR_WORDS 3456
#define XB_SPIN_CAP (1u << 18)

__device__ __forceinline__ unsigned xb_ld(unsigned* p)              { return __hip_atomic_load(p, __ATOMIC_RELAXED, __HIP_MEMORY_SCOPE_AGENT); }
__device__ __forceinline__ unsigned xb_add(unsigned* p, unsigned v) { return __hip_atomic_fetch_add(p, v, __ATOMIC_RELAXED, __HIP_MEMORY_SCOPE_AGENT); }
__device__ __forceinline__ unsigned xb_xcc_id() { return (unsigned)__builtin_amdgcn_s_getreg((3 << 11) | 20) & 0xFu; }
#define XB_SPIN(cond, bar) do { unsigned _sp = 0; while (cond) { __builtin_amdgcn_s_sleep(1); \
    if ((++_sp & 255u) == 0u) { if (xb_ld(&(bar)[XB_TMO])) break; if (_sp > XB_SPIN_CAP) { atomicAdd(&(bar)[XB_TMO], 1u); break; } } } } while (0)

struct XcdBarrier {
    unsigned* bar; unsigned x;
    volatile LAS unsigned* st;
};

__device__ __forceinline__ XcdBarrier xcd_barrier_post(unsigned* bar, volatile LAS unsigned* st) {
    XcdBarrier b; b.bar = bar; b.x = xb_xcc_id(); b.st = st;
    if (threadIdx.x == 0) (void)xb_add(&bar[XB_XCNT(b.x)], 1u);
    return b;
}
__device__ __forceinline__ void xcd_barrier_complete(unsigned* bar, unsigned x, unsigned& nloc, unsigned& nx) {
    const unsigned G = gridDim.x * gridDim.y * gridDim.z;
    unsigned sum, cnt, mine, sp = 0u;
    for (;;) {
        sum = 0u; cnt = 0u; mine = 0u;
#pragma unroll
        for (unsigned j = 0; j < 16; ++j) { const unsigned c = xb_ld(&bar[XB_XCNT(j)]); sum += c; cnt += (c > 0u) ? 1u : 0u; mine = (j == x) ? c : mine; }
        if (sum == G) break;
        __builtin_amdgcn_s_sleep(1);
        if ((++sp & 255u) == 0u) { if (xb_ld(&bar[XB_TMO])) break; if (sp > XB_SPIN_CAP) { atomicAdd(&bar[XB_TMO], 1u); break; } }
    }
    nloc = mine > 0u ? mine : 1u; nx = cnt > 0u ? cnt : 1u;
}

__device__ __forceinline__ void xcd_barrier(const XcdBarrier& b) {
    asm volatile("s_waitcnt vmcnt(0)" ::: "memory");
    __syncthreads();
    if (threadIdx.x == 0) {
        unsigned* bar = b.bar;
        __builtin_amdgcn_s_waitcnt(0);
        unsigned nloc = b.st[0], nx = b.st[1];
        if (nloc == 0u) { xcd_barrier_complete(bar, b.x, nloc, nx); b.st[0] = nloc; b.st[1] = nx; }
        const unsigned old = xb_add(&bar[XB_XSUB(b.x)], 1u);
        const unsigned gen = old / nloc;
        if (old + 1u == (gen + 1u) * nloc) {
            __builtin_amdgcn_fence(__ATOMIC_RELEASE, "agent");
            asm volatile("s_waitcnt vmcnt(0)" ::: "memory");
            const unsigned og = xb_add(&bar[XB_TOP], 1u);
            const unsigned tg = og / nx;
            if (og + 1u == (tg + 1u) * nx) xb_add(&bar[XB_TOPGEN], 1u);
            else XB_SPIN(xb_ld(&bar[XB_TOPGEN]) == tg, bar);
            __builtin_amdgcn_fence(__ATOMIC_ACQUIRE, "agent");
            xb_add(&bar[XB_XGEN(b.x)], 1u);
            asm volatile("s_waitcnt vmcnt(0)" ::: "memory");
        } else {
            XB_SPIN(xb_ld(&bar[XB_XGEN(b.x)]) == gen, bar);
            __builtin_amdgcn_fence(__ATOMIC_ACQUIRE, "agent");
            asm volatile("s_waitcnt vmcnt(0)" ::: "memory");
        }
    }
    __syncthreads();
}

__global__ void __launch_bounds__(512, 2) fwd_kernel(Params p) {
    extern __shared__ __attribute__((aligned(16))) unsigned char smem[];
    LAS unsigned char* lds = (LAS unsigned char*)smem;
    cg::grid_group grid = cg::this_grid();
    unsigned char* ws = p.ws;
    const int lo = p.ph_lo, hi = p.ph_hi, G = gridDim.x, bid = blockIdx.x;
#ifndef PHASE_MASK
#define PHASE_MASK 0xFF
#endif
#define IN(k) (((PHASE_MASK >> (k)) & 1) && lo <= (k) && (k) < hi)
    XcdBarrier xbar; xbar.bar = (unsigned*)(ws + WS_BAR); xbar.x = 0; xbar.st = (volatile LAS unsigned*)(lds + 147456);
    const bool multi = (hi - lo) > 1;
    if (multi) { if (threadIdx.x < 2) xbar.st[threadIdx.x] = 0u; __syncthreads(); xbar = xcd_barrier_post((unsigned*)(ws + WS_BAR), (volatile LAS unsigned*)(lds + 147456)); }
#define SEAM(k) do { if (IN(k) && IN((k) + 1)) xcd_barrier(xbar); } while (0)
    if (hi == 1000) grid.sync();
    if (IN(0)) p0_prep(p, lds);
    SEAM(0);
    if (IN(1)) {
        pg8::Gemm g{(const bf16_t*)(ws + WS_B), (const bf16_t*)(ws + WS_WIN), T, INW, DM}; pg8::StaticOrder S; S.init(T, INW, G, bid);
        EpiG1 E{(bf16_t*)(ws + WS_Q), (bf16_t*)(ws + WS_K), (bf16_t*)(ws + WS_VT), (bf16_t*)(ws + WS_U), (bf16_t*)(ws + WS_C), (bf16_t*)(ws + WS_D), (float*)(ws + WS_KMP), p.q_norm_g, p.k_norm_g, p.b_gate, (const float2*)(ws + WS_CS)};
        pg8::gemm_phase<EpiG1>(lds, g, S, E);
    }
    SEAM(1);
    if (IN(2)) {
        for (int it = bid; it < 1024; it += G) { const int xcd = it & 7, rest = it >> 3, s_ = rest & 31, kk = rest >> 5; const int j_ = (s_ + 16 * (kk >> 1)) & 31, i = (kk & 1) ? 31 - j_ : j_;
            attn_item<0>(p, lds, kk * 8 + xcd, i, (bf16_t*)(ws + WS_AP)); }
        for (int un = bid; un < 512; un += G) pool_unit(p, un, (bf16_t*)(ws + WS_AP));
        __syncthreads();
    }
#ifdef PROBE_VARIANTS
#if PROBE_VARIANTS == 12
    if (lo == 12) { pg8::Gemm g{(const bf16_t*)(ws + WS_C), (const bf16_t*)(ws + WS_WUP), T, FF2, DM}; pg8::StaticOrder S; S.init(T, FF2, G, bid); EpiNull<true> E{(float*)(ws + WS_END)}; pg8::gemm_phase<EpiNull<true>>(lds, g, S, E); }
#elif PROBE_VARIANTS == 13
    if (lo == 13) { pg8::Gemm g{(const bf16_t*)(ws + WS_ACT), (const bf16_t*)(ws + WS_WD), T, DM, FF}; pg8::StaticOrder S; S.init(T, DM, G, bid); EpiNull<false> E{(float*)(ws + WS_END)}; pg8::gemm_phase<EpiNull<false>>(lds, g, S, E); }
#elif PROBE_VARIANTS == 14
    if (lo == 14) { pg8::Gemm g{(const bf16_t*)(ws + WS_B), (const bf16_t*)(ws + WS_WIN), T, INW, DM}; pg8::StaticOrder S; S.init(T, INW, G, bid); EpiNull<true> E{(float*)(ws + WS_END)}; pg8::gemm_phase<EpiNull<true>>(lds, g, S, E); }
#elif PROBE_VARIANTS == 8
    if (lo == 8) for (int it = bid; it < 1024; it += G) { const int xcd = it & 7, rest = it >> 3, i = rest & 31, kk = rest >> 5; attn_item<0>(p, lds, kk * 8 + xcd, i, (bf16_t*)(ws + WS_END)); }
#elif PROBE_VARIANTS == 9
    if (lo == 9) for (int un = bid; un < 512; un += G) pool_unit(p, un, (bf16_t*)(ws + WS_END));
#elif PROBE_VARIANTS == 10
    if (lo == 10) for (int it = bid; it < 1024; it += G) { const int xcd = it & 7, rest = it >> 3, i = rest & 31, kk = rest >> 5; attn_item<1>(p, lds, kk * 8 + xcd, i, (bf16_t*)(ws + WS_END)); }
#elif PROBE_VARIANTS == 11
    if (lo == 11) for (int it = bid; it < 1024; it += G) { const int xcd = it & 7, rest = it >> 3, i = rest & 31, kk = rest >> 5; attn_item<2>(p, lds, kk * 8 + xcd, i, (bf16_t*)(ws + WS_END)); }
#endif
#endif
    SEAM(2);
    if (IN(3)) {
        pg8::Gemm g{(const bf16_t*)(ws + WS_AP), (const bf16_t*)(ws + WS_W2), T, DM, DM}; pg8::StaticOrder S; S.init(T, DM, G, bid);
        EpiG2 E{(const bf16_t*)(ws + WS_C), (const bf16_t*)(ws + WS_D), (bf16_t*)(ws + WS_Q)};
        pg8::gemm_phase<EpiG2>(lds, g, S, E);
    }
    SEAM(3);
    if (IN(4)) {
        pg8::Gemm g{(const bf16_t*)(ws + WS_Q), (const bf16_t*)(ws + WS_WO), T, DM, DM}; pg8::StaticOrder S; S.init(T, DM, G, bid);
        EpiG3 E{(const bf16_t*)(ws + WS_B), (const float*)(ws + WS_RINV), (bf16_t*)(ws + WS_C), (float*)(ws + WS_SSQ)};
        pg8::gemm_phase<EpiG3>(lds, g, S, E);
    }
    SEAM(4);
    if (IN(5)) {
        pg8::Gemm g{(const bf16_t*)(ws + WS_C), (const bf16_t*)(ws + WS_WUP), T, FF2, DM}; pg8::StaticOrder S; S.init(T, FF2, G, bid);
        EpiG4 E{(const float*)(ws + WS_SSQ), p.conv_w, p.conv_b, (bf16_t*)(ws + WS_ACT), (float*)(ws + WS_HALO), (LAS float*)(lds + 131072)};
        if ((threadIdx.x & 63) == 0) ((LAS int*)(lds + 131072))[(threadIdx.x >> 6) * 400 + 384] = -1;
        pg8::gemm_phase<EpiG4>(lds, g, S, E);
    }
    if (IN(5) && IN(7)) xcd_barrier(xbar);
    if (IN(7)) {
        pg8::Gemm g{(const bf16_t*)(ws + WS_ACT), (const bf16_t*)(ws + WS_WD), T, DM, FF}; pg8::StaticOrder S; S.init(T, DM, G, bid);
        { Unit u; int last = -1; for (int ui = 0; S.next(ui, u); ++ui) { if (u.pm != last) fixup_panel(p, u.pm); last = u.pm; } __syncthreads(); }
        EpiG5 E{(const bf16_t*)(ws + WS_C), p.out};
        pg8::gemm_phase<EpiG5>(lds, g, S, E);
    }
#undef IN
#undef SEAM
}

#ifndef N_LAUNCH_MODE
#define N_LAUNCH_MODE 1
#endif

extern "C" void kernel_launch(void* const* d_in, const int* in_sizes, int n_in, void* d_out, int out_size, void* d_ws, size_t ws_size, hipStream_t stream) {
    static int grid = 0;
    if (grid == 0) {
        if (n_in != 16 || out_size != T * DM || ws_size < WS_END + 64 * MiB) { fprintf(stderr, "kernel_launch: unexpected shapes (n_in %d out %d ws %zu need %zu)\n", n_in, out_size, ws_size, (size_t)WS_END); grid = -1; return; }
        int dev = 0, cus = 0, per_cu = 0;
        hipGetDevice(&dev); hipDeviceGetAttribute(&cus, hipDeviceAttributeMultiprocessorCount, dev);
        if (hipFuncSetAttribute((const void*)fwd_kernel, hipFuncAttributeMaxDynamicSharedMemorySize, LDS_BYTES) != hipSuccess) { fprintf(stderr, "kernel_launch: hipFuncSetAttribute failed\n"); grid = -1; return; }
        if (hipOccupancyMaxActiveBlocksPerMultiprocessor(&per_cu, (const void*)fwd_kernel, 512, LDS_BYTES) != hipSuccess || per_cu < 1) { fprintf(stderr, "kernel_launch: occupancy query says %d\n", per_cu); per_cu = 1; }
        (void)hipGetLastError();
        grid = cus < 256 ? cus : 256;
    }
    if (grid < 0) return;
    Params p{};
    p.x = (const float*)d_in[0]; p.norm_mix_g = (const float*)d_in[1]; p.w_in = (const float*)d_in[2]; p.b_gate = (const float*)d_in[3]; p.q_norm_g = (const float*)d_in[4]; p.k_norm_g = (const float*)d_in[5];
    p.w_pool = (const float*)d_in[6]; p.pool_scale = (const float*)d_in[7]; p.w_ba = (const float*)d_in[8]; p.w_bp = (const float*)d_in[9]; p.w_out = (const float*)d_in[10]; p.norm_ffn_g = (const float*)d_in[11];
    p.w_up = (const float*)d_in[12]; p.conv_w = (const float*)d_in[13]; p.conv_b = (const float*)d_in[14]; p.w_down = (const float*)d_in[15];
    p.out = (float*)d_out; p.ws = (unsigned char*)d_ws;
#if N_LAUNCH_MODE == 1
    p.ph_lo = 0; p.ph_hi = 8;
    if (hipMemsetAsync((unsigned char*)d_ws + WS_BAR, 0, 16384, stream) != hipSuccess) { fprintf(stderr, "kernel_launch: memset of the barrier words failed\n"); return; }
    void* args[] = {&p};
    hipError_t e = hipLaunchCooperativeKernel((const void*)fwd_kernel, dim3(grid), dim3(512), args, LDS_BYTES, stream);
    if (e != hipSuccess) fprintf(stderr, "cooperative launch failed: %s (grid %d)\n", hipGetErrorString(e), grid);
#else
    for (int k = 0; k < 8; ++k) { p.ph_lo = k; p.ph_hi = k + 1; hipLaunchKernelGGL(fwd_kernel, dim3(grid), dim3(512), LDS_BYTES, stream, p);
#ifdef PROBE_G5_EARLY
        if (k == 3) { Params pv = p; pv.ph_lo = 7; pv.ph_hi = 8; hipLaunchKernelGGL(fwd_kernel, dim3(grid), dim3(512), LDS_BYTES, stream, pv); }
#endif
#ifdef PROBE_PHASE
        if (k == PROBE_PHASE) hipLaunchKernelGGL(fwd_kernel, dim3(grid), dim3(512), LDS_BYTES, stream, p);
#endif
#ifdef PROBE_VARIANTS
        if (k == (PROBE_VARIANTS == 12 ? 5 : PROBE_VARIANTS == 13 ? 6 : PROBE_VARIANTS == 14 ? 1 : 2)) { Params pv = p; pv.ph_lo = PROBE_VARIANTS; pv.ph_hi = PROBE_VARIANTS + 1; hipLaunchKernelGGL(fwd_kernel, dim3(grid), dim3(512), LDS_BYTES, stream, pv); }
#endif
    }
#endif
}
```
